# Optimizing an MI355X kernel written in HIP

```python
import math
import jax, jax.numpy as jnp
from jax import lax
import numpy as np

D_MODEL = 1024
BATCH = 8
SEQ = 2048
DEPTH = 2
DEC_BATCH = 16
DEC_SEQ = 32
PAST_LEN = 4096

CHUNK = 64
CONV_W = 4
EPS = 1e-6
LRU_HEADS = 4
LRU_WIDTH = 256
LRU_BLOCK = LRU_WIDTH // LRU_HEADS
LRU_C = 8.0
FOX_HEADS = 8
FOX_HEAD_DIM = 64
FOX_WIDTH = FOX_HEADS * FOX_HEAD_DIM
Q_BLOCK = 128
SSD_HEADS = 4
SSD_HEAD_DIM = 64
SSD_WIDTH = SSD_HEADS * SSD_HEAD_DIM
SSD_GROUPS = 2
SSD_HPG = SSD_HEADS // SSD_GROUPS
D_STATE = 128
SSD_CONV_DIM = SSD_WIDTH + 2 * SSD_GROUPS * D_STATE
SSD_BLOCK = CHUNK
D_MIX = LRU_WIDTH + FOX_WIDTH + SSD_WIDTH
IN_SIZES = (LRU_WIDTH, LRU_WIDTH, FOX_WIDTH, FOX_WIDTH, FOX_WIDTH, FOX_HEADS, SSD_WIDTH, SSD_CONV_DIM, SSD_HEADS)
IN_OFFSETS = tuple(int(v) for v in np.cumsum(IN_SIZES)[:-1])
D_IN = int(sum(IN_SIZES))
D_FF = 2816
N_SUB = 3
STATE_KEYS = ("fox_k", "fox_v", "fox_logf", "lru_conv", "lru_h", "ssd_conv", "ssd_h")

kernel_name = "hybrid_streaming_encoder_step"

F32 = jnp.float32


def rmsnorm(x, g):
    xf = x.astype(F32)
    r = lax.rsqrt(jnp.mean(xf * xf, axis=-1, keepdims=True) + EPS)
    return (xf * r).astype(x.dtype) * g


def causal_conv(x, prev, w, b):
    L = x.shape[1]
    xp = jnp.concatenate([prev.astype(x.dtype), x], axis=1)
    y = b + w[0] * xp[:, 0:L]
    for k in range(1, CONV_W):
        y = y + w[k] * xp[:, k:k + L]
    return y, xp[:, -(CONV_W - 1):]


def swiglu(h, wg, wu, wd):
    return (jax.nn.silu(h @ wg) * (h @ wu)) @ wd


def rg_lru(x, h0, wa, ba, wx, bx, lam):
    b_, L, _ = x.shape
    xf = x.astype(F32)
    xb = xf.reshape(b_, L, LRU_HEADS, LRU_BLOCK)
    r = jax.nn.sigmoid(jnp.einsum('blhi,hij->blhj', xb, wa.astype(F32)).reshape(b_, L, LRU_WIDTH) + ba)
    i = jax.nn.sigmoid(jnp.einsum('blhi,hij->blhj', xb, wx.astype(F32)).reshape(b_, L, LRU_WIDTH) + bx)
    log_a = -LRU_C * r * jax.nn.softplus(-lam.astype(F32))
    a = jnp.exp(log_a)
    u = jnp.sqrt(-jnp.expm1(2.0 * log_a)) * (i * xf)

    def comb(left, right):
        al, bl = left
        ar, br = right
        return al * ar, ar * bl + br

    a_cum, b_cum = lax.associative_scan(comb, (a, u), axis=1)
    h = a_cum * h0.astype(F32)[:, None] + b_cum
    return h, h[:, -1]


def fox_block(q, k, v, fq, fk, pos_q, pos_k):
    s = jnp.einsum('bqhd,bkhd->bhqk', q, k, preferred_element_type=F32) * (FOX_HEAD_DIM ** -0.5)
    s = s + (jnp.transpose(fq, (0, 2, 1))[:, :, :, None] - jnp.transpose(fk, (0, 2, 1))[:, :, None, :])
    mask = pos_k[None, :] <= pos_q[:, None]
    s = jnp.where(mask, s, -1e30)
    p = jax.nn.softmax(s, axis=-1)
    return jnp.einsum('bhqk,bkhd->bqhd', p.astype(v.dtype), v)


def fox_prompt(q, k, v, logf):
    b_, S, H, dh = q.shape
    F = jnp.cumsum(logf, axis=1)
    nblk = S // Q_BLOCK
    qb = jnp.transpose(q.reshape(b_, nblk, Q_BLOCK, H, dh), (1, 0, 2, 3, 4))
    fb = jnp.transpose(F.reshape(b_, nblk, Q_BLOCK, H), (1, 0, 2, 3))
    pos_q = jnp.arange(S, dtype=jnp.int32).reshape(nblk, Q_BLOCK)
    pos_k = jnp.arange(S, dtype=jnp.int32)
    out = lax.map(lambda a: fox_block(a[0], k, v, a[1], F, a[2], pos_k), (qb, fb, pos_q))
    return jnp.transpose(out, (1, 0, 2, 3, 4)).reshape(b_, S, H, dh)


def fox_sample(q, k, v, logf, ck, cv, clogf):
    P = ck.shape[1]
    T = q.shape[1]
    k_all = jnp.concatenate([ck.astype(k.dtype), k], axis=1)
    v_all = jnp.concatenate([cv.astype(v.dtype), v], axis=1)
    F = jnp.cumsum(jnp.concatenate([clogf.astype(F32), logf], axis=1), axis=1)
    pos_k = jnp.arange(P + T, dtype=jnp.int32)
    pos_q = P + jnp.arange(T, dtype=jnp.int32)
    return fox_block(q, k_all, v_all, F[:, P:], F, pos_q, pos_k)


def ssd(x, dt, A, Bm, Cm, Dp, h0, block):
    b_, L = x.shape[:2]
    nc = L // block
    xg = x.reshape(b_, nc, block, SSD_GROUPS, SSD_HPG, SSD_HEAD_DIM)
    dtg = dt.reshape(b_, nc, block, SSD_GROUPS, SSD_HPG)
    Bc = Bm.reshape(b_, nc, block, SSD_GROUPS, D_STATE)
    Cc = Cm.reshape(b_, nc, block, SSD_GROUPS, D_STATE)
    cum = jnp.cumsum(dtg * A.reshape(SSD_GROUPS, SSD_HPG), axis=2)
    seg = cum[:, :, :, None] - cum[:, :, None, :]
    causal = jnp.tril(jnp.ones((block, block), dtype=bool))[:, :, None, None]
    Lmat = jnp.exp(jnp.where(causal, seg, -jnp.inf))
    CB = jnp.einsum('bcqgn,bcsgn->bcqsg', Cc, Bc)
    dx = dtg[..., None] * xg
    y_diag = jnp.einsum('bcqsgh,bcsghp->bcqghp', CB[..., None] * Lmat, dx)
    decay_end = jnp.exp(cum[:, :, -1:] - cum)
    states = jnp.einsum('bcsgn,bcsghp->bcghpn', Bc, decay_end[..., None] * dx)
    chunk_decay = jnp.exp(cum[:, :, -1])

    def step(h, inp):
        st, dec = inp
        return dec[..., None, None] * h + st, h

    h0g = h0.astype(F32).reshape(b_, SSD_GROUPS, SSD_HPG, SSD_HEAD_DIM, D_STATE)
    h_last, h_starts = lax.scan(step, h0g, (jnp.transpose(states, (1, 0, 2, 3, 4, 5)),
                                            jnp.transpose(chunk_decay, (1, 0, 2, 3))))
    h_starts = jnp.transpose(h_starts, (1, 0, 2, 3, 4, 5))
    y_off = jnp.einsum('bcqgn,bcghpn->bcqghp', Cc, h_starts) * jnp.exp(cum)[..., None]
    y = y_diag + y_off + Dp.astype(F32).reshape(SSD_GROUPS, SSD_HPG)[..., None] * xg
    return y.reshape(b_, L, SSD_HEADS, SSD_HEAD_DIM), h_last.reshape(b_, SSD_HEADS, SSD_HEAD_DIM, D_STATE)


def token_mix(h, lp, prev, ssd_block):
    b_, L, _ = h.shape
    proj = h @ lp["w_in"]
    lru_x, lru_g, q, k, v, f_raw, z, xbc, dt_raw = jnp.split(proj, IN_OFFSETS, axis=-1)
    u, lru_conv_new = causal_conv(lru_x, prev["lru_conv"], lp["lru_conv_w"], lp["lru_conv_b"])
    hA, lru_h_new = rg_lru(u, prev["lru_h"], lp["lru_wa"], lp["lru_ba"], lp["lru_wx"], lp["lru_bx"], lp["lru_lambda"])
    yA = hA.astype(h.dtype) * jax.nn.gelu(lru_g)
    q = q.reshape(b_, L, FOX_HEADS, FOX_HEAD_DIM)
    k = k.reshape(b_, L, FOX_HEADS, FOX_HEAD_DIM)
    v = v.reshape(b_, L, FOX_HEADS, FOX_HEAD_DIM)
    logf = jax.nn.log_sigmoid((f_raw + lp["fox_f_bias"]).astype(F32))
    if prev["fox_k"] is None:
        o = fox_prompt(q, k, v, logf)
    else:
        o = fox_sample(q, k, v, logf, prev["fox_k"], prev["fox_v"], prev["fox_logf"])
    yB = o.reshape(b_, L, FOX_WIDTH).astype(h.dtype)
    xbc, ssd_conv_new = causal_conv(xbc, prev["ssd_conv"], lp["ssd_conv_w"], lp["ssd_conv_b"])
    xbc = jax.nn.silu(xbc).astype(F32)
    xs, Bm, Cm = jnp.split(xbc, (SSD_WIDTH, SSD_WIDTH + SSD_GROUPS * D_STATE), axis=-1)
    dt = jax.nn.softplus((dt_raw + lp["ssd_dt_bias"]).astype(F32))
    A = -jnp.exp(lp["ssd_a_log"].astype(F32))
    yc, ssd_h_new = ssd(xs.reshape(b_, L, SSD_HEADS, SSD_HEAD_DIM), dt, A,
                        Bm.reshape(b_, L, SSD_GROUPS, D_STATE), Cm.reshape(b_, L, SSD_GROUPS, D_STATE),
                        lp["ssd_d"], prev["ssd_h"], ssd_block)
    yC = rmsnorm(yc.reshape(b_, L, SSD_WIDTH).astype(h.dtype) * jax.nn.silu(z), lp["ssd_norm_w"])
    y = jnp.concatenate([yA, yB, yC], axis=-1) @ lp["w_out"]
    new = {"fox_k": k, "fox_v": v, "fox_logf": logf, "lru_conv": lru_conv_new, "lru_h": lru_h_new,
           "ssd_conv": ssd_conv_new, "ssd_h": ssd_h_new}
    return y, new


def trunk(x, c, caches, params):
    b_, L, _ = x.shape
    ssd_block = SSD_BLOCK if caches is None else L
    new_states = {name: [] for name in STATE_KEYS}
    for l in range(DEPTH):
        lp = {name: arr[l] for name, arr in params.items()}
        if caches is None:
            prev = {"fox_k": None, "fox_v": None, "fox_logf": None,
                    "lru_conv": jnp.zeros((b_, CONV_W - 1, LRU_WIDTH), x.dtype),
                    "lru_h": jnp.zeros((b_, LRU_WIDTH), F32),
                    "ssd_conv": jnp.zeros((b_, CONV_W - 1, SSD_CONV_DIM), x.dtype),
                    "ssd_h": jnp.zeros((b_, SSD_HEADS, SSD_HEAD_DIM, D_STATE), F32)}
        else:
            prev = {name: arr[l] for name, arr in caches.items()}
        mod = (jax.nn.silu(c) @ lp["w_mod"] + lp["b_mod"]).reshape(b_, N_SUB, 3, D_MODEL)
        shift, scale, gate = mod[:, :, 0, None], mod[:, :, 1, None], mod[:, :, 2, None]

        def pre(x_, j):
            return rmsnorm(x_, lp["norm_pre"][j]) * (1.0 + scale[:, j]) + shift[:, j]

        def post(x_, y_, j, w):
            return x_ + w * gate[:, j] * rmsnorm(y_, lp["norm_post"][j])

        y = swiglu(pre(x, 0), lp["ffn_w_gate"][0], lp["ffn_w_up"][0], lp["ffn_w_down"][0])
        x = post(x, y, 0, 0.5)
        y, st = token_mix(pre(x, 1), lp, prev, ssd_block)
        x = post(x, y, 1, 1.0)
        y = swiglu(pre(x, 2), lp["ffn_w_gate"][1], lp["ffn_w_up"][1], lp["ffn_w_down"][1])
        x = post(x, y, 2, 0.5)
        for name in STATE_KEYS:
            new_states[name].append(st[name])
    return x, {name: jnp.stack(v, axis=0) for name, v in new_states.items()}


def setup_inputs(seed: int = 0) -> dict:
    key = jax.random.key(seed)
    ks = iter(jax.random.split(key, 48))

    def nrm(shape, s=1.0):
        return s * jax.random.normal(next(ks), shape, F32)

    def unif(shape, lo, hi):
        return jax.random.uniform(next(ks), shape, F32, lo, hi)

    a_root = unif((DEPTH, LRU_WIDTH), 0.9, 0.999) ** (1.0 / LRU_C)
    lru_lambda = jnp.log(a_root) - jnp.log1p(-a_root)
    dt0 = jnp.exp(unif((DEPTH, SSD_HEADS), math.log(1e-3), math.log(1e-1)))
    ssd_dt_bias = dt0 + jnp.log(-jnp.expm1(-dt0))
    return {
        "x_prompt": nrm((BATCH, SEQ, D_MODEL)),
        "x_sample": nrm((DEC_BATCH, DEC_SEQ, D_MODEL)),
        "c_prompt": nrm((BATCH, D_MODEL)),
        "c_sample": nrm((DEC_BATCH, D_MODEL)),
        "cache_fox_k": nrm((DEPTH, DEC_BATCH, PAST_LEN, FOX_HEADS, FOX_HEAD_DIM)),
        "cache_fox_v": nrm((DEPTH, DEC_BATCH, PAST_LEN, FOX_HEADS, FOX_HEAD_DIM)),
        "cache_fox_logf": jax.nn.log_sigmoid(nrm((DEPTH, DEC_BATCH, PAST_LEN, FOX_HEADS)) + 3.0),
        "state_lru_conv": nrm((DEPTH, DEC_BATCH, CONV_W - 1, LRU_WIDTH)),
        "state_lru_h": nrm((DEPTH, DEC_BATCH, LRU_WIDTH), 0.5),
        "state_ssd_conv": nrm((DEPTH, DEC_BATCH, CONV_W - 1, SSD_CONV_DIM)),
        "state_ssd_h": nrm((DEPTH, DEC_BATCH, SSD_HEADS, SSD_HEAD_DIM, D_STATE), 0.1),
        "w_mod": nrm((DEPTH, D_MODEL, N_SUB * 3 * D_MODEL), 0.5 * D_MODEL ** -0.5),
        "b_mod": nrm((DEPTH, N_SUB * 3 * D_MODEL), 0.1),
        "norm_pre": 1.0 + nrm((DEPTH, N_SUB, D_MODEL), 0.05),
        "norm_post": 1.0 + nrm((DEPTH, N_SUB, D_MODEL), 0.05),
        "ffn_w_gate": nrm((DEPTH, 2, D_MODEL, D_FF), D_MODEL ** -0.5),
        "ffn_w_up": nrm((DEPTH, 2, D_MODEL, D_FF), D_MODEL ** -0.5),
        "ffn_w_down": nrm((DEPTH, 2, D_FF, D_MODEL), D_FF ** -0.5),
        "w_in": nrm((DEPTH, D_MODEL, D_IN), D_MODEL ** -0.5),
        "w_out": nrm((DEPTH, D_MIX, D_MODEL), D_MIX ** -0.5),
        "lru_conv_w": nrm((DEPTH, CONV_W, LRU_WIDTH), CONV_W ** -0.5),
        "lru_conv_b": nrm((DEPTH, LRU_WIDTH), 0.02),
        "lru_wa": nrm((DEPTH, LRU_HEADS, LRU_BLOCK, LRU_BLOCK), LRU_BLOCK ** -0.5),
        "lru_ba": nrm((DEPTH, LRU_WIDTH), 0.02),
        "lru_wx": nrm((DEPTH, LRU_HEADS, LRU_BLOCK, LRU_BLOCK), LRU_BLOCK ** -0.5),
        "lru_bx": nrm((DEPTH, LRU_WIDTH), 0.02),
        "lru_lambda": lru_lambda,
        "fox_f_bias": unif((DEPTH, FOX_HEADS), 1.0, 4.0),
        "ssd_conv_w": nrm((DEPTH, CONV_W, SSD_CONV_DIM), CONV_W ** -0.5),
        "ssd_conv_b": nrm((DEPTH, SSD_CONV_DIM), 0.02),
        "ssd_dt_bias": ssd_dt_bias,
        "ssd_a_log": jnp.log(unif((DEPTH, SSD_HEADS), 1.0, 16.0)),
        "ssd_d": 1.0 + nrm((DEPTH, SSD_HEADS), 0.1),
        "ssd_norm_w": 1.0 + nrm((DEPTH, SSD_WIDTH), 0.05),
    }


def reference(x_prompt, x_sample, c_prompt, c_sample, cache_fox_k, cache_fox_v, cache_fox_logf,
              state_lru_conv, state_lru_h, state_ssd_conv, state_ssd_h,
              w_mod, b_mod, norm_pre, norm_post, ffn_w_gate, ffn_w_up, ffn_w_down, w_in, w_out,
              lru_conv_w, lru_conv_b, lru_wa, lru_ba, lru_wx, lru_bx, lru_lambda, fox_f_bias,
              ssd_conv_w, ssd_conv_b, ssd_dt_bias, ssd_a_log, ssd_d, ssd_norm_w):
    params = {"w_mod": w_mod, "b_mod": b_mod, "norm_pre": norm_pre, "norm_post": norm_post,
              "ffn_w_gate": ffn_w_gate, "ffn_w_up": ffn_w_up, "ffn_w_down": ffn_w_down,
              "w_in": w_in, "w_out": w_out, "lru_conv_w": lru_conv_w, "lru_conv_b": lru_conv_b,
              "lru_wa": lru_wa, "lru_ba": lru_ba, "lru_wx": lru_wx, "lru_bx": lru_bx, "lru_lambda": lru_lambda,
              "fox_f_bias": fox_f_bias, "ssd_conv_w": ssd_conv_w, "ssd_conv_b": ssd_conv_b,
              "ssd_dt_bias": ssd_dt_bias, "ssd_a_log": ssd_a_log, "ssd_d": ssd_d, "ssd_norm_w": ssd_norm_w}
    caches = {"fox_k": cache_fox_k, "fox_v": cache_fox_v, "fox_logf": cache_fox_logf,
              "lru_conv": state_lru_conv, "lru_h": state_lru_h, "ssd_conv": state_ssd_conv, "ssd_h": state_ssd_h}
    y_prompt, sp = trunk(x_prompt, c_prompt, None, params)
    y_sample, ss = trunk(x_sample, c_sample, caches, params)
    return (y_prompt, y_sample,
            sp["fox_k"], sp["fox_v"], sp["fox_logf"], sp["lru_conv"], sp["lru_h"], sp["ssd_conv"], sp["ssd_h"],
            ss["fox_k"], ss["fox_v"], ss["fox_logf"], ss["lru_conv"], ss["lru_h"], ss["ssd_conv"], ss["ssd_h"])
```

```cpp
#include <hip/hip_runtime.h>
#include <hip/hip_cooperative_groups.h>
#include <cstdio>
namespace cg = cooperative_groups;

#ifndef COOP
#define COOP 1
#endif

#ifndef REP_GEMM
#define REP_GEMM 1
#endif
#ifndef REP_IN
#define REP_IN REP_GEMM
#endif
#ifndef REP_OUT
#define REP_OUT REP_GEMM
#endif
#ifndef REP_GU
#define REP_GU REP_GEMM
#endif
#ifndef REP_DN
#define REP_DN REP_GEMM
#endif
#ifndef REP_LRUF
#define REP_LRUF 1
#endif
#ifndef REP_COMB
#define REP_COMB 1
#endif
#ifndef REP_NORM
#define REP_NORM 1
#endif
#ifndef REP_PREP
#define REP_PREP 1
#endif
#ifndef REP_N0
#define REP_N0 1
#endif
#ifndef REP_ATTP
#define REP_ATTP 1
#endif
#ifndef REP_ATTS
#define REP_ATTS 1
#endif
#ifndef REP_LRU1
#define REP_LRU1 1
#endif
#ifndef REP_SSD1
#define REP_SSD1 1
#endif
#ifndef REP_M3
#define REP_M3 1
#endif
#ifndef REP_SYNC
#define REP_SYNC 1
#endif
#define LAS __attribute__((address_space(3)))
typedef unsigned short bf16_t;
typedef short bf16x8 __attribute__((ext_vector_type(8)));
typedef float f32x4 __attribute__((ext_vector_type(4)));
typedef unsigned u32x4 __attribute__((ext_vector_type(4)));
typedef unsigned u32x2 __attribute__((ext_vector_type(2)));

constexpr int DM = 1024, TP = 16384, TS = 512, TT = TP + TS, NSEQ = 24;
constexpr int DFF = 2816, NGU = 2 * DFF, NIN = 3328, DIN = 3084;
constexpr int NCI = 272;
constexpr float EPS = 1e-6f;
constexpr int LDS_MAIN = 147456, LDS_BYTES = LDS_MAIN + 16;

constexpr size_t O_Y = 0;
constexpr size_t O_PK = (size_t)TT * DM;
constexpr size_t O_PV = O_PK + (size_t)2 * TP * 512;
constexpr size_t O_PLOGF = O_PV + (size_t)2 * TP * 512;
constexpr size_t O_PLCONV = O_PLOGF + (size_t)2 * TP * 8;
constexpr size_t O_PLH = O_PLCONV + 2 * 8 * 3 * 256;
constexpr size_t O_PSCONV = O_PLH + 2 * 8 * 256;
constexpr size_t O_PSH = O_PSCONV + 2 * 8 * 3 * 768;
constexpr size_t O_SK = O_PSH + (size_t)2 * 8 * 32768;
constexpr size_t O_SV = O_SK + (size_t)2 * TS * 512;
constexpr size_t O_SLOGF = O_SV + (size_t)2 * TS * 512;
constexpr size_t O_SLCONV = O_SLOGF + 2 * TS * 8;
constexpr size_t O_SLH = O_SLCONV + 2 * 16 * 3 * 256;
constexpr size_t O_SSCONV = O_SLH + 2 * 16 * 256;
constexpr size_t O_SSH = O_SSCONV + 2 * 16 * 3 * 768;

constexpr size_t al256(size_t x) { return (x + 255) & ~(size_t)255; }
constexpr size_t W_GU = 0;
constexpr size_t W_D = al256(W_GU + (size_t)4 * NGU * DM * 2);
constexpr size_t W_IN = al256(W_D + (size_t)4 * DM * DFF * 2);
constexpr size_t W_OUT = al256(W_IN + (size_t)2 * NIN * DM * 2);
constexpr size_t W_MOD = al256(W_OUT + (size_t)2 * DM * DM * 2);
constexpr size_t W_FC = al256(W_MOD + (size_t)2 * NSEQ * 9216 * 4);
constexpr size_t W_X = al256(W_FC + (size_t)2 * 16 * 4096 * 8 * 4);
constexpr size_t W_H = al256(W_X + (size_t)TT * DM * 4);
constexpr size_t W_ACT = al256(W_H + (size_t)TT * DM * 2);
constexpr size_t W_Y = al256(W_ACT + (size_t)TT * DFF * 2);
constexpr size_t W_PROJ = al256(W_Y + (size_t)TT * DM * 4);
constexpr size_t W_QB = al256(W_PROJ + (size_t)TT * NIN * 4);
constexpr size_t W_KB = al256(W_QB + (size_t)TT * 512 * 2);
constexpr size_t W_VB = al256(W_KB + (size_t)TT * 512 * 2);
constexpr size_t W_MIX = al256(W_VB + (size_t)TT * 512 * 2);
constexpr size_t W_HLOC = al256(W_MIX + (size_t)TT * DM * 2);
constexpr size_t W_ACUM = al256(W_HLOC + (size_t)TT * 256 * 4);
constexpr size_t W_AGGA = al256(W_ACUM + (size_t)TT * 256 * 4);
constexpr size_t W_AGGB = al256(W_AGGA + (size_t)NCI * 256 * 4);
constexpr size_t W_XACT = al256(W_AGGB + (size_t)NCI * 256 * 4);
constexpr size_t W_DTB = al256(W_XACT + (size_t)TT * 768 * 4);
constexpr size_t W_CUMB = al256(W_DTB + (size_t)TT * 4 * 4);
constexpr size_t W_STATES = al256(W_CUMB + (size_t)TT * 4 * 4);
constexpr size_t W_CDEC = al256(W_STATES + (size_t)NCI * 32768 * 4);
constexpr size_t W_YBUF = al256(W_CDEC + (size_t)NCI * 4 * 4);
constexpr size_t W_PO = al256(W_YBUF + (size_t)TT * 256 * 4);
constexpr size_t W_PM = al256(W_PO + (size_t)1024 * 32 * 64 * 4);
constexpr size_t W_PL = al256(W_PM + (size_t)1024 * 32 * 4);
constexpr size_t W_YS = al256(W_PL + (size_t)1024 * 32 * 4);
constexpr size_t W_X2 = al256(W_YS + (size_t)11 * TS * DM * 4);
constexpr size_t W_XB16 = al256(W_X2 + (size_t)TT * DM * 4);
constexpr size_t W_HS16 = al256(W_XB16 + (size_t)TT * 512 * 2);
constexpr size_t W_BAR = al256(W_HS16 + (size_t)256 * 32768 * 2);
constexpr size_t W_END = al256(W_BAR + (size_t)4096 * 4);

struct Params {
    const float* in[34];
    float* out;
    unsigned char* ws;
    int ph_lo, ph_hi;
};
enum { I_XP = 0, I_XS, I_CP, I_CS, I_CK, I_CV, I_CLOGF, I_SLCONV, I_SLH, I_SSCONV, I_SSH, I_WMOD, I_BMOD, I_NPRE, I_NPOST, I_WG, I_WU, I_WD, I_WIN, I_WOUT,
       I_LCW, I_LCB, I_LWA, I_LBA, I_LWX, I_LBX, I_LLAM, I_FBIAS, I_SCW, I_SCB, I_SDTB, I_SALOG, I_SD, I_SNW };

__device__ __forceinline__ int fresh_tid() { int t = threadIdx.x; asm volatile("" : "+v"(t)); return t; }
__device__ __forceinline__ unsigned cvt_pk_bf16(float lo, float hi) { unsigned r; asm volatile("v_cvt_pk_bf16_f32 %0, %1, %2" : "=v"(r) : "v"(lo), "v"(hi)); return r; }
__device__ __forceinline__ bf16_t f2bf(float f) { return (bf16_t)(cvt_pk_bf16(f, 0.f) & 0xffffu); }
__device__ __forceinline__ float wave_sum(float v) {
#pragma unroll
    for (int o = 32; o > 0; o >>= 1) v += __shfl_xor(v, o);
    return v;
}
__device__ __forceinline__ float sigmoid_f(float x) { return __builtin_amdgcn_rcpf(1.f + __expf(-x)); }
__device__ __forceinline__ float silu_f(float x) { return x * __builtin_amdgcn_rcpf(1.f + __expf(-x)); }
__device__ __forceinline__ float softplus_f(float x) { return fmaxf(x, 0.f) + log1pf(__expf(-fabsf(x))); }
__device__ __forceinline__ float logsigmoid_f(float x) { return fminf(x, 0.f) - log1pf(__expf(-fabsf(x))); }
__device__ __forceinline__ float gelu_tanh_f(float x) { const float u = 0.7978845608028654f * (x + 0.044715f * x * x * x); return x * sigmoid_f(2.f * u); }
__device__ __forceinline__ int seq_of_row(int r) { return r < TP ? (r >> 11) : 8 + ((r - TP) >> 5); }


#define XB_TMO      128
#define XB_XCNT(j)  (256  + 64 * (j))
#define XB_XSUB(j)  (1280 + 64 * (j))
#define XB_XGEN(j)  (2304 + 64 * (j))
#define XB_TOP      3328
#define XB_TOPGEN   3392
#define XCD_BAR_WORDS 3456
#define XB_SPIN_CAP (1u << 22)
__device__ __forceinline__ unsigned xb_ld(unsigned* p)              { return __hip_atomic_load(p, __ATOMIC_RELAXED, __HIP_MEMORY_SCOPE_AGENT); }
__device__ __forceinline__ unsigned xb_add(unsigned* p, unsigned v) { return __hip_atomic_fetch_add(p, v, __ATOMIC_RELAXED, __HIP_MEMORY_SCOPE_AGENT); }
__device__ __forceinline__ unsigned xb_xcc_id() { return (unsigned)__builtin_amdgcn_s_getreg((3 << 11) | 20) & 0xFu; }
#define XB_SPIN(cond, bar) do { unsigned _sp = 0; while (cond) { __builtin_amdgcn_s_sleep(1); \
    if ((++_sp & 255u) == 0u) { if (xb_ld(&(bar)[XB_TMO])) break; if (_sp > XB_SPIN_CAP) { atomicAdd(&(bar)[XB_TMO], 1u); break; } } } } while (0)
struct XcdBarrier { unsigned* bar; unsigned x; volatile LAS unsigned* st; };
__device__ __forceinline__ XcdBarrier xcd_barrier_post(unsigned* bar, volatile LAS unsigned* st) {
    XcdBarrier b; b.bar = bar; b.x = xb_xcc_id(); b.st = st;
    if (threadIdx.x == 0) (void)xb_add(&bar[XB_XCNT(b.x)], 1u);
    return b;
}
__device__ __forceinline__ void xcd_barrier_complete(unsigned* bar, unsigned x, unsigned& nloc, unsigned& nx) {
    const unsigned G = gridDim.x * gridDim.y * gridDim.z;
    unsigned sum, cnt, mine, sp = 0u;
    for (;;) {
        sum = 0u; cnt = 0u; mine = 0u;
#pragma unroll
        for (unsigned j = 0; j < 16; ++j) { const unsigned c = xb_ld(&bar[XB_XCNT(j)]); sum += c; cnt += (c > 0u) ? 1u : 0u; mine = (j == x) ? c : mine; }
        if (sum == G) break;
        __builtin_amdgcn_s_sleep(1);
        if ((++sp & 255u) == 0u) { if (xb_ld(&bar[XB_TMO])) break; if (sp > XB_SPIN_CAP) { atomicAdd(&bar[XB_TMO], 1u); break; } }
    }
    nloc = mine > 0u ? mine : 1u; nx = cnt > 0u ? cnt : 1u;
}
__device__ __forceinline__ void xcd_barrier(const XcdBarrier& b) {
    asm volatile("s_waitcnt vmcnt(0)" ::: "memory");
    __syncthreads();
    if (threadIdx.x == 0) {
        unsigned* bar = b.bar;
        __builtin_amdgcn_s_waitcnt(0);
        unsigned nloc = b.st[0], nx = b.st[1];
        if (nloc == 0u) { xcd_barrier_complete(bar, b.x, nloc, nx); b.st[0] = nloc; b.st[1] = nx; }
        const unsigned old = xb_add(&bar[XB_XSUB(b.x)], 1u);
        const unsigned gen = old / nloc;
        if (old + 1u == (gen + 1u) * nloc) {
            __builtin_amdgcn_fence(__ATOMIC_RELEASE, "agent");
            asm volatile("s_waitcnt vmcnt(0)" ::: "memory");
            const unsigned og = xb_add(&bar[XB_TOP], 1u);
            const unsigned tg = og / nx;
            if (og + 1u == (tg + 1u) * nx) xb_add(&bar[XB_TOPGEN], 1u);
            else XB_SPIN(xb_ld(&bar[XB_TOPGEN]) == tg, bar);
            __builtin_amdgcn_fence(__ATOMIC_ACQUIRE, "agent");
            xb_add(&bar[XB_XGEN(b.x)], 1u);
            asm volatile("s_waitcnt vmcnt(0)" ::: "memory");
        } else {
            XB_SPIN(xb_ld(&bar[XB_XGEN(b.x)]) == gen, bar);
            __builtin_amdgcn_fence(__ATOMIC_ACQUIRE, "agent");
            asm volatile("s_waitcnt vmcnt(0)" ::: "memory");
        }
    }
    __syncthreads();
}

struct CItem { int seq, c, L, row0, b; bool prompt, lastc; };
__device__ __forceinline__ CItem citem(int ci) {
    CItem it;
    if (ci < 256) { it.prompt = true; it.seq = ci >> 5; it.c = ci & 31; it.L = 64; it.row0 = it.seq * 2048 + it.c * 64; it.b = it.seq; it.lastc = (it.c == 31); }
    else { it.prompt = false; it.b = ci - 256; it.seq = 8 + it.b; it.c = 0; it.L = 32; it.row0 = TP + it.b * 32; it.lastc = true; }
    return it;
}

namespace pg8 {
constexpr int BM = 256, BK = 64, HALF = 128, HTB = HALF * BK * 2, STAGE_BYTES = 8 * HTB, NXCD = 8, WGM = 8;
__device__ __forceinline__ int lds_byte(int r, int c) { const int st = (r >> 4) * 2 + (c >> 5), rr = r & 15, cc = c & 31, ob = rr * 64 + cc * 2; return st * 1024 + (ob ^ (((ob >> 9) & 1) << 5)); }
__device__ __forceinline__ void stage_rc(int b, int& R, int& C) { const int st = b / 1024, sb = b % 1024, swz = sb ^ (((sb >> 9) & 1) << 5); R = (st >> 1) * 16 + swz / 64; C = (st & 1) * 32 + (swz % 64) / 2; }
__device__ __forceinline__ int perm32(int rho) { const int n = rho >> 4, i = rho & 15; return 8 * (i >> 2) + 4 * n + (i & 3); }
struct Unit { int pm, pn, k0, nt, slab; };
struct Gemm { const bf16_t* A; const bf16_t* Bt; int lda, ldb; };
struct StaticOrder {
    int nM, nN, nwg, G, c, ntk;
    __device__ void init(int M, int N, int K, int G_, int c_) { nM = M / BM; nN = N / BM; nwg = nM * nN; G = G_; c = c_; ntk = K / BK; }
    __device__ bool next(int i, Unit& u) const {
        const long L = (long)i * G + c; if (L >= nwg) return false;
        int wgid = (int)L; { const int q = nwg / NXCD, r = nwg % NXCD, xcd = wgid % NXCD, off = wgid / NXCD; wgid = (xcd < r ? xcd * (q + 1) : r * (q + 1) + (xcd - r) * q) + off; }
        const int nig = WGM * nN, gid = wgid / nig, fm = gid * WGM, gsz = (nM - fm) < WGM ? (nM - fm) : WGM;
        u.pm = fm + ((wgid % nig) % gsz); u.pn = (wgid % nig) / gsz; u.k0 = 0; u.nt = ntk; u.slab = 0; return true;
    }
    __device__ __forceinline__ void a_ready(const Unit&) const {}
    __device__ __forceinline__ void done(const Unit&) const {}
};

struct SampleSplitOrder {
    StaticOrder P; int nslice;
    __device__ void init(int N, int K, int G_, int c_) { P.init(TP, N, K, G_, c_); nslice = K / 256; }
    __device__ bool next(int i, Unit& u) const {
        const long L = (long)i * P.G + P.c;
        if (L < P.nwg) return P.next(i, u);
        const int e = (int)(L - P.nwg); if (e >= 2 * P.nN * nslice) return false;
        const int tile = e / nslice, s = e % nslice; u.pm = 64 + tile / P.nN; u.pn = tile % P.nN; u.k0 = s * 256; u.nt = 4; u.slab = s; return true;
    }
    __device__ __forceinline__ void a_ready(const Unit&) const {}
    __device__ __forceinline__ void done(const Unit&) const {}
};

struct EpiF32 {
    static constexpr bool PERM = false;
    float* C; float* S; int ldc;
    __device__ __forceinline__ void operator()(const f32x4 (&acc)[2][2][4][2], const Unit& u, int wr, int wc, int fr, int fq) const {
        const int row0 = u.pm * BM + wr * 64 + fr, col0 = u.pn * BM + wc * 32 + 4 * fq;
        float* base = u.pm >= 64 ? S + ((long)u.slab * TS - TP) * (long)ldc : C;
#pragma unroll
        for (int ai = 0; ai < 2; ++ai)
#pragma unroll
            for (int m = 0; m < 4; ++m) { float* rowp = base + (size_t)(row0 + ai * HALF + m * 16) * ldc + col0;
#pragma unroll
                for (int bj = 0; bj < 2; ++bj)
#pragma unroll
                    for (int n = 0; n < 2; ++n) *(f32x4*)(rowp + bj * HALF + n * 16) = acc[ai][bj][m][n]; }
    }
};
struct EpiY {
    static constexpr bool PERM = true;
    bf16_t* C; float* S;
    __device__ __forceinline__ void operator()(const f32x4 (&acc)[2][2][4][2], const Unit& u, int wr, int wc, int fr, int fq) const {
        const int row0 = u.pm * BM + wr * 64 + fr, col0 = u.pn * BM + wc * 32 + 8 * fq;
        if (u.pm < 64) {
#pragma unroll
            for (int ai = 0; ai < 2; ++ai)
#pragma unroll
                for (int m = 0; m < 4; ++m) { bf16_t* rowp = C + (size_t)(row0 + ai * HALF + m * 16) * DM + col0;
#pragma unroll
                    for (int bj = 0; bj < 2; ++bj) { const f32x4 v0 = acc[ai][bj][m][0], v1 = acc[ai][bj][m][1];
                        u32x4 w; w.x = cvt_pk_bf16(v0[0], v0[1]); w.y = cvt_pk_bf16(v0[2], v0[3]); w.z = cvt_pk_bf16(v1[0], v1[1]); w.w = cvt_pk_bf16(v1[2], v1[3]);
                        *(u32x4*)(rowp + bj * HALF) = w; } }
        } else {
            float* base = S + ((long)u.slab * TS - TP) * (long)DM;
#pragma unroll
            for (int ai = 0; ai < 2; ++ai)
#pragma unroll
                for (int m = 0; m < 4; ++m) { float* rowp = base + (size_t)(row0 + ai * HALF + m * 16) * DM + col0;
#pragma unroll
                    for (int bj = 0; bj < 2; ++bj) { *(f32x4*)(rowp + bj * HALF) = acc[ai][bj][m][0]; *(f32x4*)(rowp + bj * HALF + 4) = acc[ai][bj][m][1]; } }
        }
    }
};
struct EpiGU {
    static constexpr bool PERM = true;
    bf16_t* O;
    __device__ __forceinline__ void operator()(const f32x4 (&acc)[2][2][4][2], const Unit& u, int wr, int wc, int fr, int fq) const {
        const int row0 = u.pm * BM + wr * 64 + fr, col0 = u.pn * HALF + wc * 32 + 8 * fq;
#pragma unroll
        for (int ai = 0; ai < 2; ++ai)
#pragma unroll
            for (int m = 0; m < 4; ++m) { bf16_t* rowp = O + (size_t)(row0 + ai * HALF + m * 16) * DFF + col0;
                float v[8];
#pragma unroll
                for (int n = 0; n < 2; ++n)
#pragma unroll
                    for (int j = 0; j < 4; ++j) { const float gt = acc[ai][0][m][n][j], up = acc[ai][1][m][n][j]; v[n * 4 + j] = silu_f(gt) * up; }
                u32x4 w; w.x = cvt_pk_bf16(v[0], v[1]); w.y = cvt_pk_bf16(v[2], v[3]); w.z = cvt_pk_bf16(v[4], v[5]); w.w = cvt_pk_bf16(v[6], v[7]);
                *(u32x4*)rowp = w; }
    }
};
struct EpiIn {
    static constexpr bool PERM = false;
    float* proj; bf16_t* qb; bf16_t* kb; bf16_t* vb; float* kp; float* ks; float* vp; float* vs;
    __device__ __forceinline__ void operator()(const f32x4 (&acc)[2][2][4][2], const Unit& u, int wr, int wc, int fr, int fq) const {
        const int row0 = u.pm * BM + wr * 64 + fr; const int pn = u.pn;
        if (pn < 2 || pn >= 8) {
            const int col0 = pn * BM + wc * 32 + 4 * fq;
#pragma unroll
            for (int ai = 0; ai < 2; ++ai)
#pragma unroll
                for (int m = 0; m < 4; ++m) { float* rowp = proj + (size_t)(row0 + ai * HALF + m * 16) * NIN + col0;
#pragma unroll
                    for (int bj = 0; bj < 2; ++bj)
#pragma unroll
                        for (int n = 0; n < 2; ++n) *(f32x4*)(rowp + bj * HALF + n * 16) = acc[ai][bj][m][n]; }
        } else if (pn < 4) {
            const int col0 = (pn - 2) * BM + wc * 32 + 4 * fq;
#pragma unroll
            for (int ai = 0; ai < 2; ++ai)
#pragma unroll
                for (int m = 0; m < 4; ++m) { bf16_t* rowp = qb + (size_t)(row0 + ai * HALF + m * 16) * 512 + col0;
#pragma unroll
                    for (int bj = 0; bj < 2; ++bj)
#pragma unroll
                        for (int n = 0; n < 2; ++n) { const f32x4 a = acc[ai][bj][m][n]; u32x2 w; w.x = cvt_pk_bf16(a[0], a[1]); w.y = cvt_pk_bf16(a[2], a[3]); *(u32x2*)(rowp + bj * HALF + n * 16) = w; } }
        } else {
            const bool isk = pn < 6; const int col0 = ((pn - 4) & 1) * BM + wc * 32 + 4 * fq;
            bf16_t* bb = isk ? kb : vb; float* fp = isk ? kp : vp; float* fs = isk ? ks : vs;
#pragma unroll
            for (int ai = 0; ai < 2; ++ai)
#pragma unroll
                for (int m = 0; m < 4; ++m) { const int row = row0 + ai * HALF + m * 16;
                    bf16_t* rowp = bb + (size_t)row * 512 + col0;
                    float* rowf = (row < TP ? fp + (size_t)row * 512 : fs + (size_t)(row - TP) * 512) + col0;
#pragma unroll
                    for (int bj = 0; bj < 2; ++bj)
#pragma unroll
                        for (int n = 0; n < 2; ++n) { const f32x4 a = acc[ai][bj][m][n]; u32x2 w; w.x = cvt_pk_bf16(a[0], a[1]); w.y = cvt_pk_bf16(a[2], a[3]);
                            *(u32x2*)(rowp + bj * HALF + n * 16) = w; *(f32x4*)(rowf + bj * HALF + n * 16) = a; } }
        }
    }
};

template <class Epi, class Sched>
__device__ __forceinline__ void gemm_phase(LAS unsigned char* lds, const Gemm g, const Sched& S, const Epi& E) {
    const int tid = fresh_tid(), wid = __builtin_amdgcn_readfirstlane(tid >> 6), lane = tid & 63, wr = wid >> 2, wc = wid & 3, fr = lane & 15, fq = lane >> 4;
    const int lda = g.lda, ldb = g.ldb;
    unsigned voffA[2], voffB[2];
#pragma unroll
    for (int i = 0; i < 2; ++i) { int R, C; stage_rc(tid * 16 + i * 8192, R, C); const int Rb = Epi::PERM ? ((R & ~31) + perm32(R & 31)) : R;
        voffA[i] = (unsigned)(R * lda + C) * 2u; voffB[i] = (unsigned)(Rb * ldb + C) * 2u; }
    const size_t kstep = (size_t)(BK * 2);
    const size_t hstepA = (size_t)HALF * lda * 2, hstepB = (size_t)HALF * ldb * 2;
    const size_t tstepA = 2 * hstepA, tstepB = 2 * hstepB;
    const unsigned ldsw = (unsigned)wid * 1024u;
    const int aoff = lds_byte(wr * 64 + fr, fq * 8), boff = lds_byte(wc * 32 + fr, fq * 8);
#define PG8_SA(b, h) (((b) * 2 + (h)) * HTB)
#define PG8_SB(b, h) ((4 + (b) * 2 + (h)) * HTB)
#define PG8_STAGE(bufoff, gbase, voff) do { _Pragma("unroll") for (int _i = 0; _i < 2; ++_i) \
        __builtin_amdgcn_global_load_lds((const unsigned*)((const char*)(gbase) + (voff)[_i]), (LAS unsigned*)(lds + (bufoff) + ldsw + _i * 8192), 16, 0, 0); } while (0)
#define PG8_LDA(dst, b, h) do { _Pragma("unroll") for (int m = 0; m < 4; ++m) _Pragma("unroll") for (int k = 0; k < 2; ++k) dst[m][k] = *(const LAS bf16x8*)(lds + PG8_SA(b, h) + aoff + m * 2048 + k * 1024); } while (0)
#define PG8_LDB(dst, b, h) do { _Pragma("unroll") for (int n = 0; n < 2; ++n) _Pragma("unroll") for (int k = 0; k < 2; ++k) dst[n][k] = *(const LAS bf16x8*)(lds + PG8_SB(b, h) + boff + n * 2048 + k * 1024); } while (0)
#define PG8_MMA(ai, bj, At, Bt) do { __builtin_amdgcn_s_setprio(1); _Pragma("unroll") for (int m = 0; m < 4; ++m) _Pragma("unroll") for (int n = 0; n < 2; ++n) _Pragma("unroll") for (int k = 0; k < 2; ++k) \
        acc[ai][bj][m][n] = __builtin_amdgcn_mfma_f32_16x16x32_bf16(Bt[n][k], At[m][k], acc[ai][bj][m][n], 0, 0, 0); __builtin_amdgcn_s_setprio(0); } while (0)
#define PG8_WAIT_V(n) asm volatile("s_waitcnt vmcnt(" #n ")" ::: "memory")
#define PG8_WAIT_L(n) asm volatile("s_waitcnt lgkmcnt(" #n ")" ::: "memory")
#define PG8_BAR __builtin_amdgcn_s_barrier()
#define PG8_SCHED __builtin_amdgcn_sched_barrier(0)
    Unit cur, nxt; int ui = 0;
    if (!S.next(0, cur)) return;
    f32x4 acc[2][2][4][2];
#pragma unroll
    for (int a = 0; a < 2; ++a)
#pragma unroll
        for (int b = 0; b < 2; ++b)
#pragma unroll
            for (int m = 0; m < 4; ++m)
#pragma unroll
                for (int n = 0; n < 2; ++n) acc[a][b][m][n] = (f32x4){0.f, 0.f, 0.f, 0.f};
    bf16x8 At[4][2], B0[2][2], B1[2][2];
    const char* cA = (const char*)g.A + (size_t)cur.pm * tstepA + (size_t)cur.k0 * 2; const char* cB = (const char*)g.Bt + (size_t)cur.pn * tstepB + (size_t)cur.k0 * 2;
    S.a_ready(cur);
    PG8_STAGE(PG8_SB(0, 0), cB, voffB); PG8_STAGE(PG8_SA(0, 0), cA, voffA); PG8_STAGE(PG8_SB(0, 1), cB + hstepB, voffB); PG8_STAGE(PG8_SA(0, 1), cA + hstepA, voffA);
    if (wr == 1) PG8_BAR;
    PG8_WAIT_V(4); PG8_BAR;
    PG8_STAGE(PG8_SB(1, 0), cB + kstep, voffB); PG8_STAGE(PG8_SA(1, 0), cA + kstep, voffA); PG8_STAGE(PG8_SB(1, 1), cB + hstepB + kstep, voffB);
    PG8_WAIT_V(6); PG8_BAR;
    for (;;) {
        const bool has_next = S.next(ui + 1, nxt);
        const char* nA = has_next ? (const char*)g.A + (size_t)nxt.pm * tstepA + (size_t)nxt.k0 * 2 : cA; const char* nB = has_next ? (const char*)g.Bt + (size_t)nxt.pn * tstepB + (size_t)nxt.k0 * 2 : cB;
        const int nt = cur.nt;
        for (int t = 0; t < nt; t += 2) {
            const bool last = (t == nt - 2);
            const char* a1 = cA + (size_t)(t + 1) * kstep;
            const char* a2 = last ? nA : cA + (size_t)(t + 2) * kstep; const char* b2 = last ? nB : cB + (size_t)(t + 2) * kstep;
            const char* a3 = a2 + kstep; const char* b3 = b2 + kstep;
            if (last && has_next) S.a_ready(nxt);
            PG8_LDB(B0, 0, 0); PG8_SCHED; PG8_LDA(At, 0, 0); PG8_STAGE(PG8_SA(1, 1), a1 + hstepA, voffA);
            PG8_WAIT_L(8); PG8_BAR; PG8_WAIT_L(0); PG8_MMA(0, 0, At, B0); PG8_BAR; PG8_SCHED;
            PG8_LDB(B1, 0, 1); PG8_STAGE(PG8_SB(0, 0), b2, voffB);
            PG8_BAR; PG8_WAIT_L(0); PG8_MMA(0, 1, At, B1); PG8_BAR;
            PG8_LDA(At, 0, 1); PG8_STAGE(PG8_SA(0, 0), a2, voffA);
            PG8_BAR; PG8_WAIT_L(0); PG8_MMA(1, 0, At, B0); PG8_BAR; PG8_SCHED;
            PG8_STAGE(PG8_SB(0, 1), b2 + hstepB, voffB);
            PG8_WAIT_V(6); PG8_BAR; PG8_MMA(1, 1, At, B1); PG8_BAR;
            PG8_LDB(B0, 1, 0); PG8_SCHED; PG8_LDA(At, 1, 0); PG8_STAGE(PG8_SA(0, 1), a2 + hstepA, voffA);
            PG8_WAIT_L(8); PG8_BAR; PG8_WAIT_L(0); PG8_MMA(0, 0, At, B0); PG8_BAR; PG8_SCHED;
            PG8_LDB(B1, 1, 1); PG8_STAGE(PG8_SB(1, 0), b3, voffB);
            PG8_BAR; PG8_WAIT_L(0); PG8_MMA(0, 1, At, B1); PG8_BAR;
            PG8_LDA(At, 1, 1); PG8_STAGE(PG8_SA(1, 0), a3, voffA);
            PG8_BAR; PG8_WAIT_L(0); PG8_MMA(1, 0, At, B0); PG8_BAR; PG8_SCHED;
            PG8_STAGE(PG8_SB(1, 1), b3 + hstepB, voffB);
            PG8_WAIT_V(6); PG8_BAR; PG8_MMA(1, 1, At, B1); PG8_BAR;
        }
        E(acc, cur, wr, wc, fr, fq); S.done(cur);
        if (!has_next) break;
#pragma unroll
        for (int a = 0; a < 2; ++a)
#pragma unroll
            for (int b = 0; b < 2; ++b)
#pragma unroll
                for (int m = 0; m < 4; ++m)
#pragma unroll
                    for (int n = 0; n < 2; ++n) acc[a][b][m][n] = (f32x4){0.f, 0.f, 0.f, 0.f};
        cur = nxt; cA = nA; cB = nB; ++ui;
    }
    PG8_WAIT_V(0);
    if (wr == 0) PG8_BAR;
    PG8_BAR;
#undef PG8_SA
#undef PG8_SB
#undef PG8_STAGE
#undef PG8_LDA
#undef PG8_LDB
#undef PG8_MMA
#undef PG8_WAIT_V
#undef PG8_WAIT_L
#undef PG8_BAR
#undef PG8_SCHED
}
}

constexpr int NTR_GU = 4 * 88 * 4, NTR_D = 4 * 16 * 11, NTR_IN = 2 * 52 * 4, NTR_OUT = 2 * 16 * 4, NTR = NTR_GU + NTR_D + NTR_IN + NTR_OUT;
constexpr int WT_D = NTR_GU, WT_IN = NTR_GU + NTR_D, WT_OUT = NTR_GU + NTR_D + NTR_IN;
__device__ __forceinline__ void wtile(const Params& p, LAS float* fl, int tid, int tr) {
            const float* src; bf16_t* dst; int K, ldsrc, ntile, kt;
            const int n4 = (tid & 15) * 4, kr = tid >> 4;
            if (tr < NTR_GU) { const int lf = tr / 352, rem = tr % 352; ntile = rem / 4; kt = rem % 4; dst = (bf16_t*)(p.ws + W_GU) + (size_t)lf * NGU * DM; K = DM; ldsrc = DFF;
                const int np = ntile * 64 + n4; const int col = (np >> 8) * 128 + (np & 127); src = ((np >> 7) & 1 ? p.in[I_WU] : p.in[I_WG]) + (size_t)lf * DM * DFF + col; }
            else if (tr < NTR_GU + NTR_D) { tr -= NTR_GU; const int lf = tr / 176, rem = tr % 176; ntile = rem / 11; kt = rem % 11; dst = (bf16_t*)(p.ws + W_D) + (size_t)lf * DM * DFF; K = DFF; ldsrc = DM;
                src = p.in[I_WD] + (size_t)lf * DFF * DM + ntile * 64 + n4; }
            else if (tr < NTR_GU + NTR_D + NTR_IN) { tr -= NTR_GU + NTR_D; const int l = tr / 208, rem = tr % 208; ntile = rem / 4; kt = rem % 4; dst = (bf16_t*)(p.ws + W_IN) + (size_t)l * NIN * DM; K = DM; ldsrc = DIN;
                const int np = ntile * 64 + n4; const int col = np < 2048 ? np : (np < 3072 ? np + 8 : (np < 3080 ? np - 1024 : (np < 3084 ? np : -1)));
                src = col >= 0 ? p.in[I_WIN] + (size_t)l * DM * DIN + col : nullptr; }
            else { tr -= NTR_GU + NTR_D + NTR_IN; const int l = tr / 64, rem = tr % 64; ntile = rem / 4; kt = rem % 4; dst = (bf16_t*)(p.ws + W_OUT) + (size_t)l * DM * DM; K = DM; ldsrc = DM;
                src = p.in[I_WOUT] + (size_t)l * DM * DM + ntile * 64 + n4; }
            const int k0 = kt * 256;
            f32x4 v[8];
            const float* sb = src ? src + (size_t)(k0 + kr) * ldsrc : nullptr;
#pragma unroll
            for (int i = 0; i < 8; ++i) v[i] = sb ? *(const f32x4*)(sb + (size_t)(32 * i) * ldsrc) : (f32x4){0.f, 0.f, 0.f, 0.f};
#pragma unroll
            for (int i = 0; i < 8; ++i) { LAS float* d = fl + (kr + 32 * i) * 65 + n4; d[0] = v[i][0]; d[1] = v[i][1]; d[2] = v[i][2]; d[3] = v[i][3]; }
            __syncthreads();
            const int nl = tid >> 3;
#pragma unroll
            for (int r = 0; r < 4; ++r) { const int kseg = (tid & 7) * 8 + r * 64; float o[8];
#pragma unroll
                for (int j = 0; j < 8; ++j) o[j] = fl[(kseg + j) * 65 + nl];
                u32x4 w; w.x = cvt_pk_bf16(o[0], o[1]); w.y = cvt_pk_bf16(o[2], o[3]); w.z = cvt_pk_bf16(o[4], o[5]); w.w = cvt_pk_bf16(o[6], o[7]);
                *(u32x4*)(dst + (size_t)(ntile * 64 + nl) * K + k0 + kseg) = w; }
            __syncthreads();
}
__device__ __forceinline__ void wconv(const Params& p, LAS unsigned char* lds, int lo0, int n0, int lo1, int n1, int lo2, int n2, int rel, int stride) {
    const int tid = fresh_tid();
    for (int v = rel; v < n0 + n1 + n2; v += stride) { const int tr = v < n0 ? lo0 + v : (v < n0 + n1 ? lo1 + (v - n0) : lo2 + (v - n0 - n1)); wtile(p, (LAS float*)lds, tid, tr); }
}
__device__ __forceinline__ void prep_phase(const Params& p, LAS unsigned char* lds, int bid, int nb) {
    const int tid = fresh_tid();
    LAS float* fl = (LAS float*)lds;
    bool sc_ready = false;
    for (int it = bid; it < 320 + 352; it += nb) {
        if (it < 288) {
            LAS float* sc = fl; LAS float* red = fl + 24 * 1024;
            if (!sc_ready) {
                for (int i = tid; i < 24 * 1024; i += 512) { const int s = i >> 10, k = i & 1023; const float c = s < 8 ? p.in[I_CP][s * 1024 + k] : p.in[I_CS][(s - 8) * 1024 + k]; sc[i] = silu_f(c); }
                __syncthreads(); sc_ready = true;
            }
            const int l = it / 144, c0 = (it % 144) * 64, cq = (tid & 15) * 4, kg = tid >> 4;
            f32x4 acc[24];
#pragma unroll
            for (int s = 0; s < 24; ++s) acc[s] = (f32x4){0.f, 0.f, 0.f, 0.f};
            const float* w = p.in[I_WMOD] + (size_t)l * 1024 * 9216 + c0 + cq + (size_t)(kg * 32) * 9216;
#pragma unroll 1
            for (int kb = 0; kb < 32; kb += 8) {
                f32x4 wv[8];
#pragma unroll
                for (int i = 0; i < 8; ++i) wv[i] = *(const f32x4*)(w + (size_t)(kb + i) * 9216);
#pragma unroll
                for (int i = 0; i < 8; i += 4) {
#pragma unroll
                    for (int s = 0; s < 24; ++s) { const f32x4 c4 = *(const LAS f32x4*)(sc + s * 1024 + kg * 32 + kb + i); acc[s] += c4[0] * wv[i] + c4[1] * wv[i + 1] + c4[2] * wv[i + 2] + c4[3] * wv[i + 3]; } }
            }
#pragma unroll
            for (int s = 0; s < 24; ++s) {
#pragma unroll
                for (int c = 0; c < 4; ++c) { float a = acc[s][c]; a += __shfl_xor(a, 16); a += __shfl_xor(a, 32); acc[s][c] = a; } }
            if ((tid & 63) < 16) { const int wv8 = tid >> 6;
#pragma unroll
                for (int s = 0; s < 24; ++s) *(LAS f32x4*)(red + (wv8 * 24 + s) * 64 + cq) = acc[s]; }
            __syncthreads();
            float* mod = (float*)(p.ws + W_MOD);
            for (int i = tid; i < 24 * 64; i += 512) { const int s = i >> 6, cc = i & 63; float sum = p.in[I_BMOD][l * 9216 + c0 + cc];
                for (int k2 = 0; k2 < 8; ++k2) sum += red[(k2 * 24 + s) * 64 + cc];
                mod[(size_t)(l * 24 + s) * 9216 + c0 + cc] = sum; }
            __syncthreads();
        } else if (it < 320) {
            const int idx = it - 288;
            const float* base = p.in[I_CLOGF] + (size_t)idx * 4096 * 8; float* fc = (float*)(p.ws + W_FC) + (size_t)idx * 4096 * 8;
            const int head = tid & 7, seg = tid >> 3;
            const float* bp = base + (seg * 64) * 8 + head; float* fp = fc + (seg * 64) * 8 + head;
            float run = 0.f;
            for (int i0 = 0; i0 < 64; i0 += 16) { float v[16];
#pragma unroll
                for (int i = 0; i < 16; ++i) v[i] = bp[(i0 + i) * 8];
#pragma unroll
                for (int i = 0; i < 16; ++i) { run += v[i]; fp[(i0 + i) * 8] = run; } }
            __syncthreads();
            fl[seg * 8 + head] = run;
            __syncthreads();
            float off = 0.f; for (int s2 = 0; s2 < seg; ++s2) off += fl[s2 * 8 + head];
            for (int i0 = 0; i0 < 64; i0 += 16) { float v[16];
#pragma unroll
                for (int i = 0; i < 16; ++i) v[i] = fp[(i0 + i) * 8];
#pragma unroll
                for (int i = 0; i < 16; ++i) fp[(i0 + i) * 8] = v[i] + off; }
            __syncthreads();
        } else {
            wtile(p, fl, tid, it - 320);
        }
    }
}

__device__ __forceinline__ void norm_phase(const Params& p, bool first, bool last, int lpost, int jpost, float wpost, int lpre, int jpre, int nslab, int xsel, int bid, int nb) {
    const int tid = fresh_tid(), wave = tid >> 6, lane = tid & 63;
    const bf16_t* xrd = (const bf16_t*)(p.ws + (xsel ? W_X2 : W_X)); bf16_t* xws = (bf16_t*)(p.ws + (xsel ? W_X : W_X2));
    const bf16_t* Y = (const bf16_t*)(p.ws + W_Y); bf16_t* H = (bf16_t*)(p.ws + W_H); const float* mod = (const float*)(p.ws + W_MOD);
    for (int pass = 0; pass < 2; ++pass) {
        const int cstart = pass == 0 ? (bid * 8 + wave) * 8 : (wave < 2 ? TP + bid * 2 + wave : TT), cstride = pass == 0 ? nb * 64 : nb * 2, climit = pass == 0 ? TP : TT, nrow = pass == 0 ? 8 : 1;
        for (int rbase = cstart; rbase < climit; rbase += cstride) {
        const int seq = seq_of_row(rbase);
        f32x4 Av[4], Bv[4], Cv[4];
        if (!first) { const float* gate = mod + (size_t)(lpost * 24 + seq) * 9216 + jpost * 3072 + 2048; const float* gp = p.in[I_NPOST] + (lpost * 3 + jpost) * DM;
#pragma unroll
            for (int i = 0; i < 4; ++i) Av[i] = wpost * (*(const f32x4*)(gate + lane * 4 + i * 256)) * (*(const f32x4*)(gp + lane * 4 + i * 256)); }
        if (!last) { const float* mq = mod + (size_t)(lpre * 24 + seq) * 9216 + jpre * 3072; const float* gp = p.in[I_NPRE] + (lpre * 3 + jpre) * DM;
#pragma unroll
            for (int i = 0; i < 4; ++i) { const int col = lane * 4 + i * 256; Bv[i] = (*(const f32x4*)(gp + col)) * (1.f + *(const f32x4*)(mq + 1024 + col)); Cv[i] = *(const f32x4*)(mq + col); } }
        for (int rp = 0; rp < nrow; rp += 2) {
            const int nr = nrow - rp >= 2 ? 2 : 1;
            f32x4 xv[2][4], yv[2][4];
#pragma unroll
            for (int r = 0; r < 2; ++r) { if (r < nr) { const int row = rbase + rp + r;
                if (first) { const float* xin = row < TP ? p.in[I_XP] + (size_t)row * DM : p.in[I_XS] + (size_t)(row - TP) * DM;
#pragma unroll
                    for (int i = 0; i < 4; ++i) xv[r][i] = *(const f32x4*)(xin + lane * 4 + i * 256);
                } else {
#pragma unroll
                    for (int i = 0; i < 4; ++i) { const u32x2 w = *(const u32x2*)(xrd + (size_t)row * DM + lane * 4 + i * 256);
                        xv[r][i] = (f32x4){__uint_as_float(w.x << 16), __uint_as_float(w.x & 0xffff0000u), __uint_as_float(w.y << 16), __uint_as_float(w.y & 0xffff0000u)}; }
                    if (row < TP) {
#pragma unroll
                        for (int i = 0; i < 4; ++i) { const u32x2 w = *(const u32x2*)(Y + (size_t)row * DM + lane * 4 + i * 256);
                            yv[r][i] = (f32x4){__uint_as_float(w.x << 16), __uint_as_float(w.x & 0xffff0000u), __uint_as_float(w.y << 16), __uint_as_float(w.y & 0xffff0000u)}; }
                    } else {
                        const float* ys = (const float*)(p.ws + W_YS) + (size_t)(row - TP) * DM + lane * 4;
#pragma unroll
                        for (int i = 0; i < 4; ++i) yv[r][i] = *(const f32x4*)(ys + i * 256);
                        for (int s = 1; s < nslab; ++s) {
#pragma unroll
                            for (int i = 0; i < 4; ++i) yv[r][i] += *(const f32x4*)(ys + (size_t)s * TS * DM + i * 256); }
                    } } } }
#pragma unroll
            for (int r = 0; r < 2; ++r) { if (r < nr) { const int row = rbase + rp + r;
                if (!first) {
                    float ssq = 0.f;
#pragma unroll
                    for (int i = 0; i < 4; ++i) ssq += yv[r][i][0] * yv[r][i][0] + yv[r][i][1] * yv[r][i][1] + yv[r][i][2] * yv[r][i][2] + yv[r][i][3] * yv[r][i][3];
                    ssq = wave_sum(ssq);
                    const float ry = rsqrtf(ssq * (1.f / DM) + EPS);
#pragma unroll
                    for (int i = 0; i < 4; ++i) xv[r][i] += Av[i] * (yv[r][i] * ry);
                }
                if (last) {
#pragma unroll
                    for (int i = 0; i < 4; ++i) *(f32x4*)(p.out + O_Y + (size_t)row * DM + lane * 4 + i * 256) = xv[r][i];
                } else {
#pragma unroll
                    for (int i = 0; i < 4; ++i) { u32x2 w; w.x = cvt_pk_bf16(xv[r][i][0], xv[r][i][1]); w.y = cvt_pk_bf16(xv[r][i][2], xv[r][i][3]); *(u32x2*)(xws + (size_t)row * DM + lane * 4 + i * 256) = w; }
                    float ssq = 0.f;
#pragma unroll
                    for (int i = 0; i < 4; ++i) ssq += xv[r][i][0] * xv[r][i][0] + xv[r][i][1] * xv[r][i][1] + xv[r][i][2] * xv[r][i][2] + xv[r][i][3] * xv[r][i][3];
                    ssq = wave_sum(ssq);
                    const float rx = rsqrtf(ssq * (1.f / DM) + EPS);
#pragma unroll
                    for (int i = 0; i < 4; ++i) { const f32x4 hv = (xv[r][i] * rx) * Bv[i] + Cv[i];
                        u32x2 w; w.x = cvt_pk_bf16(hv[0], hv[1]); w.y = cvt_pk_bf16(hv[2], hv[3]);
                        *(u32x2*)(H + (size_t)row * DM + lane * 4 + i * 256) = w; }
                }
            } }
        }
        }
    }
}

__device__ __forceinline__ void attn_prompt_item(const Params& p, int l, int item, LAS unsigned char* lds) {
    const int tid = fresh_tid(), wave = tid >> 6, lane = tid & 63, g = lane >> 4, li = lane & 15;
    const int b = item >> 5, h = (item >> 2) & 7, pr = item & 3;
    constexpr int STG = 128 * 72 + 64 * 136;
    LAS bf16_t* KV = (LAS bf16_t*)lds;
    LAS float* Fs = (LAS float*)(lds + 2 * STG * 2); LAS float* wtot = Fs + 2048;
    const float* proj = (const float*)(p.ws + W_PROJ);
    const bf16_t* qbuf = (const bf16_t*)(p.ws + W_QB); const bf16_t* kbuf = (const bf16_t*)(p.ws + W_KB); const bf16_t* vbuf = (const bf16_t*)(p.ws + W_VB);
    bf16_t* mixed = (bf16_t*)(p.ws + W_MIX);
    const float LOG2E = 1.4426950408889634f;
    __syncthreads();
    {
        const float fb = p.in[I_FBIAS][l * 8 + h]; float v[4];
#pragma unroll
        for (int i = 0; i < 4; ++i) v[i] = logsigmoid_f(proj[(size_t)(b * 2048 + tid * 4 + i) * NIN + 3072 + h] + fb);
        v[1] += v[0]; v[2] += v[1]; v[3] += v[2];
        float inc = v[3];
#pragma unroll
        for (int o = 1; o < 64; o <<= 1) { const float n = __shfl_up(inc, o); if (lane >= o) inc += n; }
        if (lane == 63) wtot[wave] = inc;
        __syncthreads();
        float woff = 0.f; for (int w2 = 0; w2 < wave; ++w2) woff += wtot[w2];
        const float ex = inc - v[3] + woff;
#pragma unroll
        for (int i = 0; i < 4; ++i) Fs[tid * 4 + i] = -(v[i] + ex) * LOG2E;
        __syncthreads();
    }
    const int ldkey = tid >> 3, lddseg = (tid & 7) * 8;
    for (int half = 0; half < 2; ++half) {
        const int qt = half == 0 ? (7 - pr) : pr;
        const int q0 = qt * 256 + wave * 32;
        bf16x8 qf[2][2];
#pragma unroll
        for (int qb = 0; qb < 2; ++qb)
#pragma unroll
            for (int ks = 0; ks < 2; ++ks) qf[qb][ks] = *(const bf16x8*)(qbuf + (size_t)(b * 2048 + q0 + qb * 16 + li) * 512 + h * 64 + ks * 32 + g * 8);
        float mrun[2] = {-1e30f, -1e30f}, lsum[2] = {0.f, 0.f};
        f32x4 ot[2][4];
#pragma unroll
        for (int qb = 0; qb < 2; ++qb)
#pragma unroll
            for (int db = 0; db < 4; ++db) ot[qb][db] = (f32x4){0.f, 0.f, 0.f, 0.f};
        const int nks = (qt + 1) * 2;
        const size_t ro0 = (size_t)(b * 2048 + ldkey) * 512 + h * 64 + lddseg;
        u32x4 kv0 = *(const u32x4*)(kbuf + ro0), kv1 = *(const u32x4*)(kbuf + ro0 + 64 * 512), vv0 = *(const u32x4*)(vbuf + ro0), vv1 = *(const u32x4*)(vbuf + ro0 + 64 * 512);
#define ATP_STORE(Kn, Vn) do { *(LAS u32x4*)((Kn) + ldkey * 72 + lddseg) = kv0; *(LAS u32x4*)((Kn) + (ldkey + 64) * 72 + lddseg) = kv1; \
            _Pragma("unroll") for (int i = 0; i < 4; ++i) { (Vn)[(lddseg + 2 * i) * 136 + ldkey] = (bf16_t)(vv0[i] & 0xffffu); (Vn)[(lddseg + 2 * i + 1) * 136 + ldkey] = (bf16_t)(vv0[i] >> 16); \
                (Vn)[(lddseg + 2 * i) * 136 + 64 + ldkey] = (bf16_t)(vv1[i] & 0xffffu); (Vn)[(lddseg + 2 * i + 1) * 136 + 64 + ldkey] = (bf16_t)(vv1[i] >> 16); } } while (0)
        __syncthreads();
        ATP_STORE(KV, KV + 128 * 72);
        __syncthreads();
        for (int ks = 0; ks < nks; ++ks) {
            LAS bf16_t* Kst = KV + (ks & 1) * STG; LAS bf16_t* Vst = Kst + 128 * 72;
            if (ks + 1 < nks) { const size_t ro = ro0 + (size_t)((ks + 1) * 128) * 512; kv0 = *(const u32x4*)(kbuf + ro); kv1 = *(const u32x4*)(kbuf + ro + 64 * 512); vv0 = *(const u32x4*)(vbuf + ro); vv1 = *(const u32x4*)(vbuf + ro + 64 * 512); }
#pragma unroll
            for (int sub = 0; sub < 2; ++sub) {
            const int k0 = ks * 128 + sub * 64;
            LAS bf16_t* Ks = Kst + sub * 64 * 72; LAS bf16_t* Vt = Vst + sub * 64;
            if (k0 <= q0 + 31) {
                f32x4 st[2][4]; bf16x8 pf[2][2]; bf16x8 vf[2][4];
                const bool need_mask = (k0 + 63 > q0);
#define ATP_S(qb) do { _Pragma("unroll") for (int kb = 0; kb < 4; ++kb) { \
                    const bf16x8 kf0 = *(const LAS bf16x8*)(Ks + (kb * 16 + li) * 72 + g * 8), kf1 = *(const LAS bf16x8*)(Ks + (kb * 16 + li) * 72 + 32 + g * 8); \
                    f32x4 z = (f32x4){0.f, 0.f, 0.f, 0.f}; z = __builtin_amdgcn_mfma_f32_16x16x32_bf16(kf0, qf[qb][0], z, 0, 0, 0); \
                    st[qb][kb] = __builtin_amdgcn_mfma_f32_16x16x32_bf16(kf1, qf[qb][1], z, 0, 0, 0); } } while (0)
#define ATP_SOFTMAX(qb) do { const int qg = q0 + qb * 16 + li; float mx = -1e30f; \
                    if (need_mask) { _Pragma("unroll") for (int kb = 0; kb < 4; ++kb) { const f32x4 fk = *(const LAS f32x4*)(Fs + k0 + kb * 16 + g * 4); \
                            _Pragma("unroll") for (int j = 0; j < 4; ++j) { float s = st[qb][kb][j] * (0.125f * LOG2E) + fk[j]; const int kg = k0 + kb * 16 + g * 4 + j; if (kg > qg) s = -1e30f; st[qb][kb][j] = s; mx = fmaxf(mx, s); } } } \
                    else { _Pragma("unroll") for (int kb = 0; kb < 4; ++kb) { const f32x4 fk = *(const LAS f32x4*)(Fs + k0 + kb * 16 + g * 4); \
                            _Pragma("unroll") for (int j = 0; j < 4; ++j) { const float s = st[qb][kb][j] * (0.125f * LOG2E) + fk[j]; st[qb][kb][j] = s; mx = fmaxf(mx, s); } } } \
                    mx = fmaxf(mx, __shfl_xor(mx, 16)); mx = fmaxf(mx, __shfl_xor(mx, 32)); \
                    const float mn = fmaxf(mrun[qb], mx); const float alpha = __builtin_amdgcn_exp2f(mrun[qb] - mn); mrun[qb] = mn; float ps = 0.f; \
                    _Pragma("unroll") for (int kb = 0; kb < 4; ++kb) _Pragma("unroll") for (int j = 0; j < 4; ++j) { const float pv = __builtin_amdgcn_exp2f(st[qb][kb][j] - mn); st[qb][kb][j] = pv; ps += pv; } \
                    lsum[qb] = lsum[qb] * alpha + ps; \
                    _Pragma("unroll") for (int db = 0; db < 4; ++db) ot[qb][db] *= alpha; \
                    _Pragma("unroll") for (int kstep = 0; kstep < 2; ++kstep) { u32x4 w; w.x = cvt_pk_bf16(st[qb][2 * kstep][0], st[qb][2 * kstep][1]); w.y = cvt_pk_bf16(st[qb][2 * kstep][2], st[qb][2 * kstep][3]); \
                        w.z = cvt_pk_bf16(st[qb][2 * kstep + 1][0], st[qb][2 * kstep + 1][1]); w.w = cvt_pk_bf16(st[qb][2 * kstep + 1][2], st[qb][2 * kstep + 1][3]); pf[qb][kstep] = __builtin_bit_cast(bf16x8, w); } } while (0)
#define ATP_PV(qb) do { _Pragma("unroll") for (int kstep = 0; kstep < 2; ++kstep) _Pragma("unroll") for (int db = 0; db < 4; ++db) \
                    ot[qb][db] = __builtin_amdgcn_mfma_f32_16x16x32_bf16(vf[kstep][db], pf[qb][kstep], ot[qb][db], 0, 0, 0); } while (0)
                ATP_S(0);
                ATP_S(1);
                ATP_SOFTMAX(0);
#pragma unroll
                for (int kstep = 0; kstep < 2; ++kstep)
#pragma unroll
                    for (int db = 0; db < 4; ++db) { const u32x2 va = *(const LAS u32x2*)(Vt + (db * 16 + li) * 136 + kstep * 32 + g * 4), vb2 = *(const LAS u32x2*)(Vt + (db * 16 + li) * 136 + kstep * 32 + 16 + g * 4);
                        const u32x4 vc = {va.x, va.y, vb2.x, vb2.y}; vf[kstep][db] = __builtin_bit_cast(bf16x8, vc); }
                ATP_PV(0);
                ATP_SOFTMAX(1);
                ATP_PV(1);
#undef ATP_S
#undef ATP_SOFTMAX
#undef ATP_PV
            }
            }
            if (ks + 1 < nks) { LAS bf16_t* Kn = KV + ((ks + 1) & 1) * STG; ATP_STORE(Kn, Kn + 128 * 72); }
            __syncthreads();
        }
#undef ATP_STORE
#pragma unroll
        for (int qb = 0; qb < 2; ++qb) {
            float lt = lsum[qb]; lt += __shfl_xor(lt, 16); lt += __shfl_xor(lt, 32);
            const float inv = 1.f / lt; const size_t row = (size_t)(b * 2048 + q0 + qb * 16 + li);
#pragma unroll
            for (int db = 0; db < 4; ++db) { const f32x4 o = ot[qb][db] * inv; u32x2 w; w.x = cvt_pk_bf16(o[0], o[1]); w.y = cvt_pk_bf16(o[2], o[3]);
                *(u32x2*)(mixed + row * DM + 256 + h * 64 + db * 16 + g * 4) = w; }
        }
    }
    __syncthreads();
}

__device__ __forceinline__ void attn_sample_block(const Params& p, int l, int bid, int nb, LAS unsigned char* lds) {
    const int tid = fresh_tid(), wave = tid >> 6, lane = tid & 63, g = lane >> 4, li = lane & 15;
    LAS bf16_t* Vt = (LAS bf16_t*)lds + wave * (64 * 40);
    LAS float* cmb = (LAS float*)(lds + 8 * 64 * 40 * 2);
    const float* proj = (const float*)(p.ws + W_PROJ); const bf16_t* qbuf = (const bf16_t*)(p.ws + W_QB);
    const float LOG2E = 1.4426950408889634f;
    f32x4 kr[8], vr[8]; float fkr[8];
#define ATS_ISSUE(item_, step_) do { const int _bh = (item_) >> 1, _sp = (item_) & 1, _b = _bh >> 3, _h = _bh & 7; const bool _new = (step_) == 8; \
        const int _key0 = _sp * 2048 + wave * 256 + (step_) * 32; \
        const float* _kp = _new ? p.out + O_SK + (size_t)((l * 16 + _b) * 32) * 512 + _h * 64 : p.in[I_CK] + ((size_t)(l * 16 + _b) * 4096 + _key0) * 512 + _h * 64; \
        const float* _vp = _new ? p.out + O_SV + (size_t)((l * 16 + _b) * 32) * 512 + _h * 64 : p.in[I_CV] + ((size_t)(l * 16 + _b) * 4096 + _key0) * 512 + _h * 64; \
        _Pragma("unroll") for (int kb = 0; kb < 2; ++kb) _Pragma("unroll") for (int ks = 0; ks < 2; ++ks) { const float* a = _kp + (size_t)(kb * 16 + li) * 512 + ks * 32 + g * 8; kr[(kb * 2 + ks) * 2] = *(const f32x4*)a; kr[(kb * 2 + ks) * 2 + 1] = *(const f32x4*)(a + 4); } \
        _Pragma("unroll") for (int i = 0; i < 8; ++i) vr[i] = *(const f32x4*)(_vp + (size_t)(i * 4 + g) * 512 + li * 4); \
        if (!_new) { const float* _fc = (const float*)(p.ws + W_FC) + ((size_t)(l * 16 + _b) * 4096 + _key0) * 8 + _h; \
            _Pragma("unroll") for (int kb = 0; kb < 2; ++kb) _Pragma("unroll") for (int j = 0; j < 4; ++j) fkr[kb * 4 + j] = _fc[(size_t)(kb * 16 + g * 4 + j) * 8]; } \
    } while (0)
    int it = bid;
    if (it < 256) ATS_ISSUE(it, 0);
    __syncthreads();
    for (; it < 256; it += nb) {
        const int bh = it >> 1, sp = it & 1, b = bh >> 3, h = bh & 7;
        const int nst = 8 + ((sp == 1 && wave == 0) ? 1 : 0);
        const float* Fc = (const float*)(p.ws + W_FC) + (size_t)(l * 16 + b) * 4096 * 8 + h;
        float cst = lane < 32 ? logsigmoid_f(proj[(size_t)(TP + b * 32 + lane) * NIN + 3072 + h] + p.in[I_FBIAS][l * 8 + h]) : 0.f;
#pragma unroll
        for (int o = 1; o < 32; o <<= 1) { const float n = __shfl_up(cst, o); if (lane >= o) cst += n; }
        const float FcLast = Fc[4095 * 8];
        float Fq[2]; Fq[0] = (FcLast + __shfl(cst, li)) * LOG2E; Fq[1] = (FcLast + __shfl(cst, 16 + li)) * LOG2E;
        bf16x8 qf[2][2];
#pragma unroll
        for (int qb = 0; qb < 2; ++qb)
#pragma unroll
            for (int ks = 0; ks < 2; ++ks) qf[qb][ks] = *(const bf16x8*)(qbuf + (size_t)(TP + b * 32 + qb * 16 + li) * 512 + h * 64 + ks * 32 + g * 8);
        float mrun[2] = {-1e30f, -1e30f}, lsum[2] = {0.f, 0.f};
        f32x4 ot[2][4];
#pragma unroll
        for (int qb = 0; qb < 2; ++qb)
#pragma unroll
            for (int db = 0; db < 4; ++db) ot[qb][db] = (f32x4){0.f, 0.f, 0.f, 0.f};
        for (int step = 0; step < nst; ++step) {
            const bool isnew = step == 8;
            bf16x8 kf[2][2]; float fk[2][4];
#pragma unroll
            for (int kb = 0; kb < 2; ++kb)
#pragma unroll
                for (int ks = 0; ks < 2; ++ks) { const f32x4 x0 = kr[(kb * 2 + ks) * 2], x1 = kr[(kb * 2 + ks) * 2 + 1];
                    u32x4 w; w.x = cvt_pk_bf16(x0[0], x0[1]); w.y = cvt_pk_bf16(x0[2], x0[3]); w.z = cvt_pk_bf16(x1[0], x1[1]); w.w = cvt_pk_bf16(x1[2], x1[3]); kf[kb][ks] = __builtin_bit_cast(bf16x8, w); }
#pragma unroll
            for (int i = 0; i < 8; ++i) { const int key = i * 4 + g;
#pragma unroll
                for (int c = 0; c < 4; ++c) Vt[(li * 4 + c) * 40 + key] = f2bf(vr[i][c]); }
#pragma unroll
            for (int kb = 0; kb < 2; ++kb)
#pragma unroll
                for (int j = 0; j < 4; ++j) { const int kk = kb * 16 + g * 4 + j; const float cn = __shfl(cst, kk); fk[kb][j] = (isnew ? FcLast + cn : fkr[kb * 4 + j]) * LOG2E; }
            asm volatile("s_waitcnt lgkmcnt(0)" ::: "memory");
            if (step + 1 < nst) ATS_ISSUE(it, step + 1);
            else if (it + nb < 256) ATS_ISSUE(it + nb, 0);
            f32x4 st[2][2];
#pragma unroll
            for (int kb = 0; kb < 2; ++kb)
#pragma unroll
                for (int qb = 0; qb < 2; ++qb) { f32x4 z = (f32x4){0.f, 0.f, 0.f, 0.f};
                    z = __builtin_amdgcn_mfma_f32_16x16x32_bf16(kf[kb][0], qf[qb][0], z, 0, 0, 0);
                    st[qb][kb] = __builtin_amdgcn_mfma_f32_16x16x32_bf16(kf[kb][1], qf[qb][1], z, 0, 0, 0); }
#pragma unroll
            for (int qb = 0; qb < 2; ++qb) {
                const int qq = qb * 16 + li;
                float mx = -1e30f;
#pragma unroll
                for (int kb = 0; kb < 2; ++kb)
#pragma unroll
                    for (int j = 0; j < 4; ++j) { float s = st[qb][kb][j] * (0.125f * LOG2E) + (Fq[qb] - fk[kb][j]); const int kk = kb * 16 + g * 4 + j;
                        if (isnew && kk > qq) s = -1e30f; st[qb][kb][j] = s; mx = fmaxf(mx, s); }
                mx = fmaxf(mx, __shfl_xor(mx, 16)); mx = fmaxf(mx, __shfl_xor(mx, 32));
                const float mn = fmaxf(mrun[qb], mx); const float alpha = __builtin_amdgcn_exp2f(mrun[qb] - mn); mrun[qb] = mn;
                float ps = 0.f;
#pragma unroll
                for (int kb = 0; kb < 2; ++kb)
#pragma unroll
                    for (int j = 0; j < 4; ++j) { const float pv = __builtin_amdgcn_exp2f(st[qb][kb][j] - mn); st[qb][kb][j] = pv; ps += pv; }
                lsum[qb] = lsum[qb] * alpha + ps;
#pragma unroll
                for (int db = 0; db < 4; ++db) ot[qb][db] *= alpha;
            }
            bf16x8 pf[2];
#pragma unroll
            for (int qb = 0; qb < 2; ++qb) { u32x4 w; w.x = cvt_pk_bf16(st[qb][0][0], st[qb][0][1]); w.y = cvt_pk_bf16(st[qb][0][2], st[qb][0][3]);
                w.z = cvt_pk_bf16(st[qb][1][0], st[qb][1][1]); w.w = cvt_pk_bf16(st[qb][1][2], st[qb][1][3]); pf[qb] = __builtin_bit_cast(bf16x8, w); }
#pragma unroll
            for (int db = 0; db < 4; ++db) {
                const u32x2 va = *(const LAS u32x2*)(Vt + (db * 16 + li) * 40 + g * 4), vb2 = *(const LAS u32x2*)(Vt + (db * 16 + li) * 40 + 16 + g * 4);
                const u32x4 vc = {va.x, va.y, vb2.x, vb2.y}; const bf16x8 vf = __builtin_bit_cast(bf16x8, vc);
#pragma unroll
                for (int qb = 0; qb < 2; ++qb) ot[qb][db] = __builtin_amdgcn_mfma_f32_16x16x32_bf16(vf, pf[qb], ot[qb][db], 0, 0, 0);
            }
            asm volatile("s_waitcnt lgkmcnt(0)" ::: "memory");
        }
#pragma unroll
        for (int qb = 0; qb < 2; ++qb) {
            float lt = lsum[qb]; lt += __shfl_xor(lt, 16); lt += __shfl_xor(lt, 32);
            LAS float* rowp = cmb + (wave * 32 + qb * 16 + li) * 66;
#pragma unroll
            for (int db = 0; db < 4; ++db)
#pragma unroll
                for (int j = 0; j < 4; ++j) rowp[db * 16 + g * 4 + j] = ot[qb][db][j];
            if (g == 0) { rowp[64] = mrun[qb]; rowp[65] = lt; }
        }
        __syncthreads();
        {
            const int q = tid >> 4, dq = (tid & 15) * 4;
            float M = -1e30f;
#pragma unroll
            for (int w = 0; w < 8; ++w) M = fmaxf(M, cmb[(w * 32 + q) * 66 + 64]);
            float Lt = 0.f; f32x4 O = (f32x4){0.f, 0.f, 0.f, 0.f};
#pragma unroll
            for (int w = 0; w < 8; ++w) { LAS const float* rp = cmb + (w * 32 + q) * 66; const float e = __builtin_amdgcn_exp2f(rp[64] - M); Lt += rp[65] * e;
                O[0] += rp[dq] * e; O[1] += rp[dq + 1] * e; O[2] += rp[dq + 2] * e; O[3] += rp[dq + 3] * e; }
            *(f32x4*)((float*)(p.ws + W_PO) + ((size_t)it * 32 + q) * 64 + dq) = O;
            if ((tid & 15) == 0) { ((float*)(p.ws + W_PM))[it * 32 + q] = M; ((float*)(p.ws + W_PL))[it * 32 + q] = Lt; }
        }
        __syncthreads();
    }
#undef ATS_ISSUE
}

__device__ __forceinline__ void attn_sample_combine(const Params& p, int bh) {
    const int tid = fresh_tid(), q = tid >> 4, dq = (tid & 15) * 4, b = bh >> 3, h = bh & 7;
    const float* PO = (const float*)(p.ws + W_PO); const float* PM = (const float*)(p.ws + W_PM); const float* PL = (const float*)(p.ws + W_PL);
    float M = -1e30f;
#pragma unroll
    for (int s = 0; s < 2; ++s) M = fmaxf(M, PM[(bh * 2 + s) * 32 + q]);
    float Lt = 0.f; f32x4 O = (f32x4){0.f, 0.f, 0.f, 0.f};
#pragma unroll
    for (int s = 0; s < 2; ++s) { const float e = __builtin_amdgcn_exp2f(PM[(bh * 2 + s) * 32 + q] - M); Lt += PL[(bh * 2 + s) * 32 + q] * e; O += *(const f32x4*)(PO + ((size_t)(bh * 2 + s) * 32 + q) * 64 + dq) * e; }
    const float inv = 1.f / Lt; O *= inv;
    u32x2 w; w.x = cvt_pk_bf16(O[0], O[1]); w.y = cvt_pk_bf16(O[2], O[3]);
    *(u32x2*)((bf16_t*)(p.ws + W_MIX) + (size_t)(TP + b * 32 + q) * DM + 256 + h * 64 + dq) = w;
}

__device__ __forceinline__ void lru_local_item(const Params& p, int l, int ci, LAS unsigned char* lds) {
    const int tid = fresh_tid(), wave = tid >> 6, lane = tid & 63, g = lane >> 4, li = lane & 15; const CItem it = citem(ci); const int L = it.L, row0 = it.row0;
    LAS float* xs = (LAS float*)lds; LAS float* us = xs + 67 * 256;
    const float* proj = (const float*)(p.ws + W_PROJ);
    const int hd = wave >> 1, jh = wave & 1;
    __syncthreads();
    for (int i = tid; i < (L + 3) * 64; i += 512) { const int r = i >> 6, c4 = (i & 63) * 4, t = r - 3; f32x4 v;
        if (t >= 0 || (it.prompt && it.c > 0)) v = *(const f32x4*)(proj + (size_t)(row0 + t) * NIN + c4);
        else if (it.prompt) v = (f32x4){0.f, 0.f, 0.f, 0.f};
        else v = *(const f32x4*)(p.in[I_SLCONV] + ((l * 16 + it.b) * 3 + r) * 256 + c4);
        *(LAS f32x4*)(xs + r * 256 + c4) = v; }
    bf16x8 Wf[2][2][2];
#pragma unroll
    for (int gate = 0; gate < 2; ++gate)
#pragma unroll
        for (int jb = 0; jb < 2; ++jb)
#pragma unroll
            for (int ks = 0; ks < 2; ++ks) { const float* wp = (gate ? p.in[I_LWX] : p.in[I_LWA]) + (size_t)((l * 4 + hd) * 64 + ks * 32 + g * 8) * 64 + jh * 32 + jb * 16 + li;
                float w[8];
#pragma unroll
                for (int e = 0; e < 8; ++e) w[e] = wp[e * 64];
                u32x4 pk; pk.x = cvt_pk_bf16(w[0], w[1]); pk.y = cvt_pk_bf16(w[2], w[3]); pk.z = cvt_pk_bf16(w[4], w[5]); pk.w = cvt_pk_bf16(w[6], w[7]); Wf[gate][jb][ks] = __builtin_bit_cast(bf16x8, pk); }
    __syncthreads();
    {   const int ch = tid & 255, tb0 = (tid >> 8) * 32;
        if (tb0 < L) {
            const float w0 = p.in[I_LCW][(l * 4 + 0) * 256 + ch], w1 = p.in[I_LCW][(l * 4 + 1) * 256 + ch], w2 = p.in[I_LCW][(l * 4 + 2) * 256 + ch], w3 = p.in[I_LCW][(l * 4 + 3) * 256 + ch], bb = p.in[I_LCB][l * 256 + ch];
            for (int t = tb0; t < tb0 + 32; ++t) us[t * 260 + ch] = bb + w0 * xs[t * 256 + ch] + w1 * xs[(t + 1) * 256 + ch] + w2 * xs[(t + 2) * 256 + ch] + w3 * xs[(t + 3) * 256 + ch];
        } }
    __syncthreads();
    float bav[2], bxv[2], spl[2]; float Pc[2] = {1.f, 1.f}, Hc[2] = {0.f, 0.f};
#pragma unroll
    for (int jb = 0; jb < 2; ++jb) { const int ch = hd * 64 + jh * 32 + jb * 16 + li; bav[jb] = p.in[I_LBA][l * 256 + ch]; bxv[jb] = p.in[I_LBX][l * 256 + ch]; spl[jb] = softplus_f(-p.in[I_LLAM][l * 256 + ch]); }
    float* acum = (float*)(p.ws + W_ACUM); float* hloc = (float*)(p.ws + W_HLOC);
    for (int tb = 0; tb * 16 < L; ++tb) {
        bf16x8 Uf[2];
#pragma unroll
        for (int ks = 0; ks < 2; ++ks) { LAS const float* up = us + (tb * 16 + li) * 260 + hd * 64 + ks * 32 + g * 8; const f32x4 x0 = *(const LAS f32x4*)up, x1 = *(const LAS f32x4*)(up + 4);
            u32x4 pk; pk.x = cvt_pk_bf16(x0[0], x0[1]); pk.y = cvt_pk_bf16(x0[2], x0[3]); pk.z = cvt_pk_bf16(x1[0], x1[1]); pk.w = cvt_pk_bf16(x1[2], x1[3]); Uf[ks] = __builtin_bit_cast(bf16x8, pk); }
#pragma unroll
        for (int jb = 0; jb < 2; ++jb) {
            f32x4 ga = (f32x4){0.f, 0.f, 0.f, 0.f}, gx = (f32x4){0.f, 0.f, 0.f, 0.f};
#pragma unroll
            for (int ks = 0; ks < 2; ++ks) { ga = __builtin_amdgcn_mfma_f32_16x16x32_bf16(Uf[ks], Wf[0][jb][ks], ga, 0, 0, 0); gx = __builtin_amdgcn_mfma_f32_16x16x32_bf16(Uf[ks], Wf[1][jb][ks], gx, 0, 0, 0); }
            const int ch = hd * 64 + jh * 32 + jb * 16 + li;
            float Pl[4], Hl[4];
#pragma unroll
            for (int jj = 0; jj < 4; ++jj) { const int t = tb * 16 + g * 4 + jj;
                const float r = sigmoid_f(ga[jj] + bav[jb]), ig = sigmoid_f(gx[jj] + bxv[jb]); const float la = -8.f * r * spl[jb]; const float a = __expf(la);
                const float bc = sqrtf(fmaxf(1.f - a * a, 0.f)) * (ig * us[t * 260 + ch]);
                if (jj == 0) { Pl[0] = a; Hl[0] = bc; } else { Pl[jj] = Pl[jj - 1] * a; Hl[jj] = a * Hl[jj - 1] + bc; } }
            float EP = 1.f, EH = 0.f;
#pragma unroll
            for (int gg = 0; gg < 3; ++gg) { const float Pg = __shfl(Pl[3], li + 16 * gg), Hg = __shfl(Hl[3], li + 16 * gg); if (gg < g) { EH = Pg * EH + Hg; EP *= Pg; } }
            const float Pin = Pc[jb] * EP, Hin = EP * Hc[jb] + EH;
#pragma unroll
            for (int jj = 0; jj < 4; ++jj) { const size_t o = (size_t)(row0 + tb * 16 + g * 4 + jj) * 256 + ch; acum[o] = Pin * Pl[jj]; hloc[o] = Pl[jj] * Hin + Hl[jj]; }
            const float Pe = Pin * Pl[3], He = Pl[3] * Hin + Hl[3];
            Pc[jb] = __shfl(Pe, li + 48); Hc[jb] = __shfl(He, li + 48);
        }
    }
    if (g == 0) {
#pragma unroll
        for (int jb = 0; jb < 2; ++jb) { const int ch = hd * 64 + jh * 32 + jb * 16 + li; ((float*)(p.ws + W_AGGA))[ci * 256 + ch] = Pc[jb]; ((float*)(p.ws + W_AGGB))[ci * 256 + ch] = Hc[jb]; } }
    __syncthreads();
}

__device__ __forceinline__ void lru_final_item(const Params& p, int l, int ci) {
    const int tid = fresh_tid(); const CItem it = citem(ci); const int L = it.L, row0 = it.row0;
    const int ch = tid & 255, th = tid >> 8, tb = th * 32;
    const float* proj = (const float*)(p.ws + W_PROJ); const float* aggA = (const float*)(p.ws + W_AGGA); const float* aggB = (const float*)(p.ws + W_AGGB);
    const float* acum = (const float*)(p.ws + W_ACUM); const float* hloc = (const float*)(p.ws + W_HLOC); bf16_t* mixed = (bf16_t*)(p.ws + W_MIX);
    float hin = it.prompt ? 0.f : p.in[I_SLH][(l * 16 + it.b) * 256 + ch];
    for (int c2 = 0; c2 < it.c; c2 += 8) { float aa[8], ab[8];
#pragma unroll
        for (int k = 0; k < 8; ++k) { const int cc = min(c2 + k, it.c - 1); aa[k] = aggA[(ci - it.c + cc) * 256 + ch]; ab[k] = aggB[(ci - it.c + cc) * 256 + ch]; }
#pragma unroll
        for (int k = 0; k < 8; ++k) if (c2 + k < it.c) hin = aa[k] * hin + ab[k]; }
    if (tb < L) {
        for (int t0 = 0; t0 < 32; t0 += 16) {
            float av[16], hl[16], gv[16];
#pragma unroll
            for (int k = 0; k < 16; ++k) { const size_t row = (size_t)(row0 + tb + t0 + k); av[k] = acum[row * 256 + ch]; hl[k] = hloc[row * 256 + ch]; gv[k] = proj[row * NIN + 256 + ch]; }
#pragma unroll
            for (int k = 0; k < 16; ++k) { const size_t row = (size_t)(row0 + tb + t0 + k); const float hv = av[k] * hin + hl[k];
                mixed[row * DM + ch] = f2bf(hv * gelu_tanh_f(gv[k]));
                if (it.lastc && tb + t0 + k == L - 1) p.out[(it.prompt ? O_PLH + (size_t)(l * 8 + it.b) * 256 : O_SLH + (size_t)(l * 16 + it.b) * 256) + ch] = hv; }
        }
    }
    if (it.lastc) for (int i = tid; i < 3 * 256; i += 512) { const int r = i >> 8, c2 = i & 255;
        p.out[(it.prompt ? O_PLCONV + (size_t)((l * 8 + it.b) * 3 + r) * 256 : O_SLCONV + (size_t)((l * 16 + it.b) * 3 + r) * 256) + c2] = proj[(size_t)(row0 + L - 3 + r) * NIN + c2]; }
}

__device__ __forceinline__ void ssd1_item(const Params& p, int l, int ci, LAS unsigned char* lds) {
    const int tid = fresh_tid(), wave = tid >> 6, lane = tid & 63, g = lane >> 4, li = lane & 15; const CItem it = citem(ci); const int L = it.L, row0 = it.row0;
    LAS bf16_t* xdT = (LAS bf16_t*)lds; LAS bf16_t* BT = xdT + 256 * 72;
    LAS float* dts = (LAS float*)(lds + 2 * 256 * 72 * 2); LAS float* cums = dts + 256;
    const float* proj = (const float*)(p.ws + W_PROJ); float* xact = (float*)(p.ws + W_XACT);
    __syncthreads();
    if (tid < L * 4) { const int t = tid >> 2, hh = tid & 3; const float dtv = softplus_f(proj[(size_t)(row0 + t) * NIN + 3080 + hh] + p.in[I_SDTB][l * 4 + hh]);
        dts[tid] = dtv; ((float*)(p.ws + W_DTB))[(size_t)row0 * 4 + tid] = dtv; }
    for (int i = tid; i < L * 8; i += 512) { const int t = i >> 3, hh = i & 7; const float v = logsigmoid_f(proj[(size_t)(row0 + t) * NIN + 3072 + hh] + p.in[I_FBIAS][l * 8 + hh]);
        const int row = row0 + t; p.out[(row < TP ? O_PLOGF + ((size_t)l * TP + row) * 8 : O_SLOGF + ((size_t)l * TS + (row - TP)) * 8) + hh] = v; }
    if (it.lastc) for (int i = tid; i < 3 * 768; i += 512) { const int r = i / 768, c2 = i % 768;
        p.out[(it.prompt ? O_PSCONV + (size_t)((l * 8 + it.b) * 3 + r) * 768 : O_SSCONV + (size_t)((l * 16 + it.b) * 3 + r) * 768) + c2] = proj[(size_t)(row0 + L - 3 + r) * NIN + 2304 + c2]; }
    __syncthreads();
    if (tid < 256) { const int hh = tid >> 6, t = tid & 63; const float A = -expf(p.in[I_SALOG][l * 4 + hh]);
        float v = t < L ? dts[t * 4 + hh] * A : 0.f;
#pragma unroll
        for (int o = 1; o < 64; o <<= 1) { const float n = __shfl_up(v, o); if (t >= o) v += n; }
        if (t < L) { cums[t * 4 + hh] = v; ((float*)(p.ws + W_CUMB))[(size_t)(row0 + t) * 4 + hh] = v; }
        if (t == L - 1) ((float*)(p.ws + W_CDEC))[ci * 4 + hh] = expf(v); }
    __syncthreads();
    for (int task = tid; task < (L >> 3) * 192; task += 512) {
        const int tg = task / 192, ch = (task % 192) * 4, t0 = tg * 8;
        const f32x4 w0 = *(const f32x4*)(p.in[I_SCW] + (l * 4 + 0) * 768 + ch), w1 = *(const f32x4*)(p.in[I_SCW] + (l * 4 + 1) * 768 + ch), w2 = *(const f32x4*)(p.in[I_SCW] + (l * 4 + 2) * 768 + ch),
                    w3 = *(const f32x4*)(p.in[I_SCW] + (l * 4 + 3) * 768 + ch), bb = *(const f32x4*)(p.in[I_SCB] + l * 768 + ch);
        f32x4 xr[11];
#pragma unroll
        for (int r = 0; r < 11; ++r) { const int t = t0 - 3 + r;
            if (t >= 0 || (it.prompt && it.c > 0)) xr[r] = *(const f32x4*)(proj + (size_t)(row0 + t) * NIN + 2304 + ch);
            else if (it.prompt) xr[r] = (f32x4){0.f, 0.f, 0.f, 0.f};
            else xr[r] = *(const f32x4*)(p.in[I_SSCONV] + (size_t)((l * 16 + it.b) * 3 + (t + 3)) * 768 + ch); }
        f32x4 vv[8];
#pragma unroll
        for (int i = 0; i < 8; ++i) { f32x4 v = bb + w0 * xr[i] + w1 * xr[i + 1] + w2 * xr[i + 2] + w3 * xr[i + 3];
            v[0] = silu_f(v[0]); v[1] = silu_f(v[1]); v[2] = silu_f(v[2]); v[3] = silu_f(v[3]);
            *(f32x4*)(xact + (size_t)(row0 + t0 + i) * 768 + ch) = v; vv[i] = v;
            if (ch >= 256) { u32x2 w; w.x = cvt_pk_bf16(v[0], v[1]); w.y = cvt_pk_bf16(v[2], v[3]); *(u32x2*)((bf16_t*)(p.ws + W_XB16) + (size_t)(row0 + t0 + i) * 512 + ch - 256) = w; } }
        if (ch < 512) {
            if (ch < 256) { const int hh = ch >> 6; const float cl = cums[(L - 1) * 4 + hh];
#pragma unroll
                for (int i = 0; i < 8; ++i) vv[i] *= __expf(cl - cums[(t0 + i) * 4 + hh]) * dts[(t0 + i) * 4 + hh]; }
            LAS bf16_t* dst = (ch < 256 ? xdT + ch * 72 : BT + (ch - 256) * 72) + t0;
#pragma unroll
            for (int c = 0; c < 4; ++c) { u32x4 w; w.x = cvt_pk_bf16(vv[0][c], vv[1][c]); w.y = cvt_pk_bf16(vv[2][c], vv[3][c]); w.z = cvt_pk_bf16(vv[4][c], vv[5][c]); w.w = cvt_pk_bf16(vv[6][c], vv[7][c]);
                *(LAS u32x4*)(dst + c * 72) = w; }
        }
    }
    __syncthreads();
    {   const int hh = wave >> 1, ph = wave & 1, gi = hh >> 1; float* states = (float*)(p.ws + W_STATES);
#pragma unroll
        for (int pb = 0; pb < 2; ++pb) {
            bf16x8 Af[2];
#pragma unroll
            for (int ks = 0; ks < 2; ++ks) if (ks * 32 < L) Af[ks] = *(const LAS bf16x8*)(xdT + (hh * 64 + ph * 32 + pb * 16 + li) * 72 + ks * 32 + g * 8);
#pragma unroll
            for (int n8 = 0; n8 < 8; ++n8) {
                f32x4 a = (f32x4){0.f, 0.f, 0.f, 0.f};
#pragma unroll
                for (int ks = 0; ks < 2; ++ks) if (ks * 32 < L) { const bf16x8 Bf = *(const LAS bf16x8*)(BT + (gi * 128 + n8 * 16 + li) * 72 + ks * 32 + g * 8); a = __builtin_amdgcn_mfma_f32_16x16x32_bf16(Af[ks], Bf, a, 0, 0, 0); }
#pragma unroll
                for (int jj = 0; jj < 4; ++jj) states[((size_t)(ci * 4 + hh) * 64 + ph * 32 + pb * 16 + g * 4 + jj) * 128 + n8 * 16 + li] = a[jj];
            }
        }
    }
    __syncthreads();
}

__device__ __forceinline__ void ssd_scan_item(const Params& p, int l, int idx) {
    const int tid = fresh_tid(); float* states = (float*)(p.ws + W_STATES); const float* cdec = (const float*)(p.ws + W_CDEC);
    if (idx < 128) { const int seq = idx >> 4, e0 = (idx & 15) * 2048 + tid * 4, hh = e0 >> 13;
        f32x4 run = (f32x4){0.f, 0.f, 0.f, 0.f};
        for (int c0 = 0; c0 < 32; c0 += 8) { f32x4 st[8]; float dec[8];
#pragma unroll
            for (int k = 0; k < 8; ++k) { const int ci = seq * 32 + c0 + k; dec[k] = cdec[ci * 4 + hh]; st[k] = *(const f32x4*)(states + (size_t)ci * 32768 + e0); }
#pragma unroll
            for (int k = 0; k < 8; ++k) { const int ci = seq * 32 + c0 + k; *(f32x4*)(states + (size_t)ci * 32768 + e0) = run;
                u32x2 w; w.x = cvt_pk_bf16(run[0], run[1]); w.y = cvt_pk_bf16(run[2], run[3]); *(u32x2*)((bf16_t*)(p.ws + W_HS16) + (size_t)ci * 32768 + e0) = w; run = dec[k] * run + st[k]; } }
        *(f32x4*)(p.out + O_PSH + (size_t)(l * 8 + seq) * 32768 + e0) = run;
    } else { const int b = (idx - 128) >> 4, e0 = ((idx - 128) & 15) * 2048 + tid * 4, hh = e0 >> 13, ci = 256 + b;
        const f32x4 h0 = *(const f32x4*)(p.in[I_SSH] + (size_t)(l * 16 + b) * 32768 + e0); const float dec = cdec[ci * 4 + hh]; float* sp = states + (size_t)ci * 32768 + e0; const f32x4 st = *(const f32x4*)sp;
        *(f32x4*)(p.out + O_SSH + (size_t)(l * 16 + b) * 32768 + e0) = dec * h0 + st; }
}

__device__ __forceinline__ bf16x8 frag_from_f32(const float* a) {
    const f32x4 x0 = *(const f32x4*)a, x1 = *(const f32x4*)(a + 4);
    u32x4 w; w.x = cvt_pk_bf16(x0[0], x0[1]); w.y = cvt_pk_bf16(x0[2], x0[3]); w.z = cvt_pk_bf16(x1[0], x1[1]); w.w = cvt_pk_bf16(x1[2], x1[3]);
    return __builtin_bit_cast(bf16x8, w);
}
__device__ __forceinline__ void ssd3_item(const Params& p, int l, int ci, LAS unsigned char* lds) {
    const int tid = fresh_tid(), wave = tid >> 6, lane = tid & 63, g = lane >> 4, li = lane & 15; const CItem it = citem(ci); const int L = it.L, row0 = it.row0;
    const int hh = wave >> 1, qh = wave & 1, gi = hh >> 1;
    LAS bf16_t* xT = (LAS bf16_t*)lds + wave * (64 * 72);
    LAS float* cumT = (LAS float*)(lds + 8 * 64 * 72 * 2); LAS float* dtT = cumT + 256; LAS float* ssqp = dtT + 256;
    const float* xact = (const float*)(p.ws + W_XACT); const float* proj = (const float*)(p.ws + W_PROJ);
    const bf16_t* xb16 = (const bf16_t*)(p.ws + W_XB16); const bf16_t* hs16 = (const bf16_t*)(p.ws + W_HS16) + (size_t)(it.prompt ? ci : 0) * 32768;
    const float* hst = it.prompt ? (const float*)(p.ws + W_STATES) + (size_t)ci * 32768 : p.in[I_SSH] + (size_t)(l * 16 + it.b) * 32768;
    const bool qact = qh * 32 < L;
    __syncthreads();
    if (tid < L * 4) { const int t = tid >> 2, h2 = tid & 3; cumT[h2 * 64 + t] = ((const float*)(p.ws + W_CUMB))[(size_t)row0 * 4 + tid]; dtT[h2 * 64 + t] = ((const float*)(p.ws + W_DTB))[(size_t)row0 * 4 + tid]; }
    {
        for (int i = 0; i < (L >> 2); ++i) { const int s = i * 4 + g; const f32x4 v = *(const f32x4*)(xact + (size_t)(row0 + s) * 768 + hh * 64 + li * 4);
#pragma unroll
            for (int c = 0; c < 4; ++c) xT[(li * 4 + c) * 72 + s] = f2bf(v[c]); }
    }
    f32x4 yt[2][4];
#pragma unroll
    for (int qb = 0; qb < 2; ++qb)
#pragma unroll
        for (int pb = 0; pb < 4; ++pb) yt[qb][pb] = (f32x4){0.f, 0.f, 0.f, 0.f};
    bf16x8 Cf[2][4];
    f32x4 cb[2][4];
    if (qact) {
#pragma unroll
        for (int qb = 0; qb < 2; ++qb)
#pragma unroll
            for (int ks = 0; ks < 4; ++ks) Cf[qb][ks] = *(const bf16x8*)(xb16 + (size_t)(row0 + qh * 32 + qb * 16 + li) * 512 + 256 + gi * 128 + ks * 32 + g * 8);
        {   bf16x8 Bf[4][4];
#pragma unroll
            for (int sb = 0; sb < 4; ++sb)
#pragma unroll
                for (int ks = 0; ks < 4; ++ks) if (sb * 16 < L) Bf[sb][ks] = *(const bf16x8*)(xb16 + (size_t)(row0 + sb * 16 + li) * 512 + gi * 128 + ks * 32 + g * 8);
#pragma unroll
            for (int sb = 0; sb < 4; ++sb) {
                if (sb * 16 < L) {
#pragma unroll
                    for (int qb = 0; qb < 2; ++qb) { f32x4 a = (f32x4){0.f, 0.f, 0.f, 0.f};
#pragma unroll
                        for (int ks = 0; ks < 4; ++ks) a = __builtin_amdgcn_mfma_f32_16x16x32_bf16(Bf[sb][ks], Cf[qb][ks], a, 0, 0, 0);
                        cb[qb][sb] = a; }
                } else { cb[0][sb] = (f32x4){0.f, 0.f, 0.f, 0.f}; cb[1][sb] = (f32x4){0.f, 0.f, 0.f, 0.f}; }
            }
        }
        {
            bf16x8 Hf[4][4];
#pragma unroll
            for (int pb = 0; pb < 4; ++pb)
#pragma unroll
                for (int ks = 0; ks < 4; ++ks) { const size_t ho = ((size_t)hh * 64 + pb * 16 + li) * 128 + ks * 32 + g * 8; Hf[pb][ks] = it.prompt ? *(const bf16x8*)(hs16 + ho) : frag_from_f32(hst + ho); }
#pragma unroll
            for (int pb = 0; pb < 4; ++pb)
#pragma unroll
                for (int qb = 0; qb < 2; ++qb)
#pragma unroll
                    for (int ks = 0; ks < 4; ++ks) yt[qb][pb] = __builtin_amdgcn_mfma_f32_16x16x32_bf16(Hf[pb][ks], Cf[qb][ks], yt[qb][pb], 0, 0, 0);
        }
    }
    __syncthreads();
    float ssq[2] = {0.f, 0.f};
    f32x4 vv[2][4];
    if (qact) {
        bf16x8 Wf[2][2];
#pragma unroll
        for (int qb = 0; qb < 2; ++qb) {
            const int q = qh * 32 + qb * 16 + li; const float cq = cumT[hh * 64 + q]; const float eq = __expf(cq);
#pragma unroll
            for (int pb = 0; pb < 4; ++pb) yt[qb][pb] *= eq;
            float wv[4][4];
#pragma unroll
            for (int sb = 0; sb < 4; ++sb) {
                if (sb * 16 < L) {
                    const f32x4 cs = *(const LAS f32x4*)(cumT + hh * 64 + sb * 16 + g * 4), ds = *(const LAS f32x4*)(dtT + hh * 64 + sb * 16 + g * 4);
#pragma unroll
                    for (int j = 0; j < 4; ++j) { const int s = sb * 16 + g * 4 + j; wv[sb][j] = s <= q ? cb[qb][sb][j] * __expf(cq - cs[j]) * ds[j] : 0.f; }
                } else {
#pragma unroll
                    for (int j = 0; j < 4; ++j) wv[sb][j] = 0.f; }
            }
#pragma unroll
            for (int kst = 0; kst < 2; ++kst) { u32x4 w; w.x = cvt_pk_bf16(wv[2 * kst][0], wv[2 * kst][1]); w.y = cvt_pk_bf16(wv[2 * kst][2], wv[2 * kst][3]);
                w.z = cvt_pk_bf16(wv[2 * kst + 1][0], wv[2 * kst + 1][1]); w.w = cvt_pk_bf16(wv[2 * kst + 1][2], wv[2 * kst + 1][3]); Wf[qb][kst] = __builtin_bit_cast(bf16x8, w); }
        }
#pragma unroll
        for (int kst = 0; kst < 2; ++kst) {
            if (kst * 32 < L) {
#pragma unroll
                for (int pb = 0; pb < 4; ++pb) {
                    const u32x2 va = *(const LAS u32x2*)(xT + (pb * 16 + li) * 72 + kst * 32 + g * 4), vb2 = *(const LAS u32x2*)(xT + (pb * 16 + li) * 72 + kst * 32 + 16 + g * 4);
                    const u32x4 vc = {va.x, va.y, vb2.x, vb2.y}; const bf16x8 xf = __builtin_bit_cast(bf16x8, vc);
#pragma unroll
                    for (int qb = 0; qb < 2; ++qb) yt[qb][pb] = __builtin_amdgcn_mfma_f32_16x16x32_bf16(xf, Wf[qb][kst], yt[qb][pb], 0, 0, 0);
                }
            }
        }
        const float Dh = p.in[I_SD][l * 4 + hh];
#pragma unroll
        for (int qb = 0; qb < 2; ++qb) { const size_t row = (size_t)(row0 + qh * 32 + qb * 16 + li);
#pragma unroll
            for (int pb = 0; pb < 4; ++pb) { const int pc = hh * 64 + pb * 16 + g * 4;
                const f32x4 xq = *(const f32x4*)(xact + row * 768 + pc), z = *(const f32x4*)(proj + row * NIN + 2048 + pc);
                f32x4 v = yt[qb][pb] + Dh * xq;
#pragma unroll
                for (int j = 0; j < 4; ++j) { v[j] *= silu_f(z[j]); ssq[qb] += v[j] * v[j]; }
                vv[qb][pb] = v; }
            ssq[qb] += __shfl_xor(ssq[qb], 16); ssq[qb] += __shfl_xor(ssq[qb], 32);
            if (g == 0) ssqp[hh * 64 + qh * 32 + qb * 16 + li] = ssq[qb]; }
    }
    __syncthreads();
    if (qact) {
#pragma unroll
        for (int qb = 0; qb < 2; ++qb) { const int q = qh * 32 + qb * 16 + li; const float tot = ssqp[q] + ssqp[64 + q] + ssqp[128 + q] + ssqp[192 + q];
            const float r = rsqrtf(tot * (1.f / 256.f) + EPS); const size_t row = (size_t)(row0 + q);
#pragma unroll
            for (int pb = 0; pb < 4; ++pb) { const int pc = hh * 64 + pb * 16 + g * 4; const f32x4 w = *(const f32x4*)(p.in[I_SNW] + l * 256 + pc); const f32x4 o = (vv[qb][pb] * r) * w;
                u32x2 pk; pk.x = cvt_pk_bf16(o[0], o[1]); pk.y = cvt_pk_bf16(o[2], o[3]);
                *(u32x2*)((bf16_t*)(p.ws + W_MIX) + row * DM + 768 + pc) = pk; } }
    }
    __syncthreads();
}

constexpr int NPH = 2 + 2 * 12;
__global__ void __launch_bounds__(512, 2) mega(Params p) {
    extern __shared__ __attribute__((aligned(16))) unsigned char smem[];
    LAS unsigned char* lds = (LAS unsigned char*)smem;
    cg::grid_group grid = cg::this_grid();
    const int bid = blockIdx.x, nb = gridDim.x;
    int ph = 0;
    unsigned* barw = (unsigned*)(p.ws + W_BAR);
    volatile LAS unsigned* bst = (volatile LAS unsigned*)(lds + LDS_MAIN);
    XcdBarrier xb; xb.bar = barw; xb.x = 0; xb.st = bst;
#if COOP
    if (threadIdx.x < 4) bst[threadIdx.x] = 0u;
    if (bid == 0) for (int i = threadIdx.x; i < XCD_BAR_WORDS; i += 512) barw[i] = 0u;
#endif
#define PH_BEGIN if (ph >= p.ph_lo && ph < p.ph_hi) {
#define PH_END if (ph + 1 < p.ph_hi) for (int rs = 0; rs < REP_SYNC; ++rs) xcd_barrier(xb); } ++ph;
    PH_BEGIN for (int rep = 0; rep < REP_PREP; ++rep) prep_phase(p, lds, bid, nb);
        if (ph + 1 < p.ph_hi) { grid.sync(); xb = xcd_barrier_post(barw, bst); } } ++ph;
    PH_BEGIN for (int rep = 0; rep < REP_N0; ++rep) norm_phase(p, true, false, 0, 0, 0.f, 0, 0, 0, 1, bid, nb); PH_END
    for (int l = 0; l < 2; ++l) {
        const bf16_t* H = (const bf16_t*)(p.ws + W_H); const bf16_t* ACT = (const bf16_t*)(p.ws + W_ACT); const bf16_t* MIX = (const bf16_t*)(p.ws + W_MIX);
        for (int f = 0; f < 2; ++f) {
            if (f == 1) {
                PH_BEGIN {
                    pg8::Gemm g{H, (const bf16_t*)(p.ws + W_IN) + (size_t)l * NIN * DM, DM, DM}; pg8::StaticOrder S; S.init(TT, NIN, DM, nb, bid);
                    pg8::EpiIn E{(float*)(p.ws + W_PROJ), (bf16_t*)(p.ws + W_QB), (bf16_t*)(p.ws + W_KB), (bf16_t*)(p.ws + W_VB),
                                 p.out + O_PK + (size_t)l * TP * 512, p.out + O_SK + (size_t)l * TS * 512, p.out + O_PV + (size_t)l * TP * 512, p.out + O_SV + (size_t)l * TS * 512};
                    for (int rep = 0; rep < REP_IN; ++rep) pg8::gemm_phase(lds, g, S, E);
                    {
                        const int first = (66 * 13) % nb; if (bid >= first) { const int rel = bid - first, st = nb - first;
                            wconv(p, lds, WT_OUT + l * 64, 64, (l * 2 + 1) * 352, 352, WT_D + (l * 2 + 1) * 176, 176, rel, st); } } } PH_END
                PH_BEGIN {
                    for (int s = 0; s < 2; ++s) {
                        if (((s ^ (bid >> 3)) & 1) == 0) { for (int rep = 0; rep < REP_ATTP; ++rep) for (int it = bid; it < 256; it += nb) attn_prompt_item(p, l, it, lds); }
                        else { for (int rep = 0; rep < REP_ATTS; ++rep) attn_sample_block(p, l, bid, nb, lds); } }
                    for (int rep = 0; rep < REP_LRU1; ++rep) { for (int it = bid; it < 256; it += nb) lru_local_item(p, l, it, lds); for (int k = 0; k < 16; ++k) if ((32 + k) % nb == bid) lru_local_item(p, l, 256 + k, lds); }
                    for (int rep = 0; rep < REP_SSD1; ++rep) { for (int it = bid; it < 256; it += nb) ssd1_item(p, l, it, lds); for (int k = 0; k < 16; ++k) if ((16 + k) % nb == bid) ssd1_item(p, l, 256 + k, lds); } } PH_END
                for (int sub = 0; sub < 2; ++sub) {
                    PH_BEGIN {
                        if (sub == 0) {
                            for (int it = bid; it < 384; it += nb) ssd_scan_item(p, l, it);
                            for (int rep = 0; rep < REP_LRUF; ++rep) for (int it = bid; it < NCI; it += nb) lru_final_item(p, l, it);
                            for (int rep = 0; rep < REP_COMB; ++rep) for (int it = bid; it < 128; it += nb) attn_sample_combine(p, it);
                        }
                        const int first = sub == 0 ? 256 + (nb - 1 - bid) : bid, limit = sub == 0 ? NCI : 256;
                        for (int rep = 0; rep < REP_M3; ++rep) for (int it = first; it < limit; it += nb) ssd3_item(p, l, it, lds);
                    } PH_END
                }
                PH_BEGIN {
                    pg8::Gemm g{MIX, (const bf16_t*)(p.ws + W_OUT) + (size_t)l * DM * DM, DM, DM}; pg8::SampleSplitOrder S; S.init(DM, DM, nb, bid);
                    pg8::EpiY E{(bf16_t*)(p.ws + W_Y), (float*)(p.ws + W_YS)}; for (int rep = 0; rep < REP_OUT; ++rep) pg8::gemm_phase(lds, g, S, E); } PH_END
                PH_BEGIN for (int rep = 0; rep < REP_NORM; ++rep) norm_phase(p, false, false, l, 1, 1.0f, l, 2, 4, (l * 3 + 1) & 1, bid, nb); PH_END
            }
            PH_BEGIN {
                pg8::Gemm g{H, (const bf16_t*)(p.ws + W_GU) + (size_t)(l * 2 + f) * NGU * DM, DM, DM}; pg8::StaticOrder S; S.init(TT, NGU, DM, nb, bid);
                pg8::EpiGU E{(bf16_t*)(p.ws + W_ACT)}; for (int rep = 0; rep < REP_GU; ++rep) pg8::gemm_phase(lds, g, S, E);
                {
                    const int first = (66 * 22) % nb; if (bid >= first) { const int rel = bid - first, st = nb - first;
                        const int lo0 = f == 0 ? WT_D + (l * 2) * 176 : 2 * 352, n0 = f == 0 ? 176 : (l == 0 ? 352 : 0), lo1 = WT_IN + l * 208, n1 = f == 0 ? 208 : 0;
                        wconv(p, lds, lo0, n0, lo1, n1, 0, 0, rel, st); } } } PH_END
            PH_BEGIN {
                pg8::Gemm g{ACT, (const bf16_t*)(p.ws + W_D) + (size_t)(l * 2 + f) * DM * DFF, DFF, DFF}; pg8::SampleSplitOrder S; S.init(DM, DFF, nb, bid);
                pg8::EpiY E{(bf16_t*)(p.ws + W_Y), (float*)(p.ws + W_YS)}; for (int rep = 0; rep < REP_DN; ++rep) pg8::gemm_phase(lds, g, S, E); } PH_END
            if (f == 0) { PH_BEGIN for (int rep = 0; rep < REP_NORM; ++rep) norm_phase(p, false, false, l, 0, 0.5f, l, 1, 11, (l * 3) & 1, bid, nb); PH_END }
            else { PH_BEGIN for (int rep = 0; rep < REP_NORM; ++rep) norm_phase(p, false, l == 1, l, 2, 0.5f, l + 1, 0, 11, (l * 3 + 2) & 1, bid, nb); PH_END }
        }
    }
#undef PH_BEGIN
#undef PH_END
}

extern "C" void kernel_launch(void* const* d_in, const int* in_sizes, int n_in, void* d_out, int out_size, void* d_ws, size_t ws_size, hipStream_t stream) {
    static int grid = 0;
    if (grid == 0) {
        if (n_in != 34 || ws_size < W_END) { fprintf(stderr, "kernel_launch: unexpected n_in %d or ws %zu < %zu\n", n_in, ws_size, (size_t)W_END); grid = -1; return; }
        int dev = 0, cus = 0, per_cu = 0;
        (void)hipGetDevice(&dev); (void)hipDeviceGetAttribute(&cus, hipDeviceAttributeMultiprocessorCount, dev);
        if (hipFuncSetAttribute((const void*)mega, hipFuncAttributeMaxDynamicSharedMemorySize, LDS_BYTES) != hipSuccess) { fprintf(stderr, "kernel_launch: hipFuncSetAttribute failed\n"); grid = -1; return; }
        if (hipOccupancyMaxActiveBlocksPerMultiprocessor(&per_cu, (const void*)mega, 512, LDS_BYTES) != hipSuccess || per_cu < 1) { fprintf(stderr, "kernel_launch: occupancy query says %d\n", per_cu); per_cu = 1; }
        (void)hipGetLastError();
        grid = cus;
    }
    if (grid < 0) return;
    Params p{};
    for (int i = 0; i < 34; ++i) p.in[i] = (const float*)d_in[i];
    p.out = (float*)d_out; p.ws = (unsigned char*)d_ws;
#if COOP
    p.ph_lo = 0; p.ph_hi = NPH;
    void* args[] = {&p};
    hipError_t e = hipLaunchCooperativeKernel((const void*)mega, dim3(grid), dim3(512), args, LDS_BYTES, stream);
    if (e != hipSuccess) fprintf(stderr, "cooperative launch failed: %s (grid %d)\n", hipGetErrorString(e), grid);
#else
    for (int ph = 0; ph < NPH; ++ph) { p.ph_lo = ph; p.ph_hi = ph + 1; hipLaunchKernelGGL(mega, dim3(grid), dim3(512), LDS_BYTES, stream, p); }
#endif
}
```

```cpp
#include <hip/hip_runtime.h>
#include <hip/hip_cooperative_groups.h>
#include <cstdio>
namespace cg = cooperative_groups;

#ifndef COOP
#define COOP 1
#endif

#ifndef REP_GEMM
#define REP_GEMM 1
#endif
#ifndef REP_IN
#define REP_IN REP_GEMM
#endif
#ifndef REP_OUT
#define REP_OUT REP_GEMM
#endif
#ifndef REP_GU
#define REP_GU REP_GEMM
#endif
#ifndef REP_DN
#define REP_DN REP_GEMM
#endif
#ifndef REP_LRUF
#define REP_LRUF 1
#endif
#ifndef REP_COMB
#define REP_COMB 1
#endif
#ifndef REP_NORM
#define REP_NORM 1
#endif
#ifndef REP_PREP
#define REP_PREP 1
#endif
#ifndef REP_N0
#define REP_N0 1
#endif
#ifndef REP_ATTP
#define REP_ATTP 1
#endif
#ifndef REP_ATTS
#define REP_ATTS 1
#endif
#ifndef REP_LRU1
#define REP_LRU1 1
#endif
#ifndef REP_SSD1
#define REP_SSD1 1
#endif
#ifndef REP_M3
#define REP_M3 1
#endif
#ifndef REP_SYNC
#define REP_SYNC 1
#endif
#define LAS __attribute__((address_space(3)))
typedef unsigned short bf16_t;
typedef short bf16x8 __attribute__((ext_vector_type(8)));
typedef float f32x4 __attribute__((ext_vector_type(4)));
typedef unsigned u32x4 __attribute__((ext_vector_type(4)));
typedef unsigned u32x2 __attribute__((ext_vector_type(2)));

constexpr int DM = 1024, TP = 16384, TS = 512, TT = TP + TS, NSEQ = 24;
constexpr int DFF = 2816, NGU = 2 * DFF, NIN = 3328, DIN = 3084;
constexpr int NCI = 272;
constexpr float EPS = 1e-6f;
constexpr int LDS_MAIN = 147456, LDS_BYTES = LDS_MAIN + 16;

constexpr size_t O_Y = 0;
constexpr size_t O_PK = (size_t)TT * DM;
constexpr size_t O_PV = O_PK + (size_t)2 * TP * 512;
constexpr size_t O_PLOGF = O_PV + (size_t)2 * TP * 512;
constexpr size_t O_PLCONV = O_PLOGF + (size_t)2 * TP * 8;
constexpr size_t O_PLH = O_PLCONV + 2 * 8 * 3 * 256;
constexpr size_t O_PSCONV = O_PLH + 2 * 8 * 256;
constexpr size_t O_PSH = O_PSCONV + 2 * 8 * 3 * 768;
constexpr size_t O_SK = O_PSH + (size_t)2 * 8 * 32768;
constexpr size_t O_SV = O_SK + (size_t)2 * TS * 512;
constexpr size_t O_SLOGF = O_SV + (size_t)2 * TS * 512;
constexpr size_t O_SLCONV = O_SLOGF + 2 * TS * 8;
constexpr size_t O_SLH = O_SLCONV + 2 * 16 * 3 * 256;
constexpr size_t O_SSCONV = O_SLH + 2 * 16 * 256;
constexpr size_t O_SSH = O_SSCONV + 2 * 16 * 3 * 768;

constexpr size_t al256(size_t x) { return (x + 255) & ~(size_t)255; }
constexpr size_t W_GU = 0;
constexpr size_t W_D = al256(W_GU + (size_t)4 * NGU * DM * 2);
constexpr size_t W_IN = al256(W_D + (size_t)4 * DM * DFF * 2);
constexpr size_t W_OUT = al256(W_IN + (size_t)2 * NIN * DM * 2);
constexpr size_t W_MOD = al256(W_OUT + (size_t)2 * DM * DM * 2);
constexpr size_t W_FC = al256(W_MOD + (size_t)2 * NSEQ * 9216 * 4);
constexpr size_t W_X = al256(W_FC + (size_t)2 * 16 * 4096 * 8 * 4);
constexpr size_t W_H = al256(W_X + (size_t)TT * DM * 4);
constexpr size_t W_ACT = al256(W_H + (size_t)TT * DM * 2);
constexpr size_t W_Y = al256(W_ACT + (size_t)TT * DFF * 2);
constexpr size_t W_PROJ = al256(W_Y + (size_t)TT * DM * 4);
constexpr size_t W_QB = al256(W_PROJ + (size_t)TT * NIN * 4);
constexpr size_t W_KB = al256(W_QB + (size_t)TT * 512 * 2);
constexpr size_t W_VB = al256(W_KB + (size_t)TT * 512 * 2);
constexpr size_t W_MIX = al256(W_VB + (size_t)TT * 512 * 2);
constexpr size_t W_HLOC = al256(W_MIX + (size_t)TT * DM * 2);
constexpr size_t W_ACUM = al256(W_HLOC + (size_t)TT * 256 * 4);
constexpr size_t W_AGGA = al256(W_ACUM + (size_t)TT * 256 * 4);
constexpr size_t W_AGGB = al256(W_AGGA + (size_t)NCI * 256 * 4);
constexpr size_t W_XACT = al256(W_AGGB + (size_t)NCI * 256 * 4);
constexpr size_t W_DTB = al256(W_XACT + (size_t)TT * 768 * 4);
constexpr size_t W_CUMB = al256(W_DTB + (size_t)TT * 4 * 4);
constexpr size_t W_STATES = al256(W_CUMB + (size_t)TT * 4 * 4);
constexpr size_t W_CDEC = al256(W_STATES + (size_t)NCI * 32768 * 4);
constexpr size_t W_YBUF = al256(W_CDEC + (size_t)NCI * 4 * 4);
constexpr size_t W_PO = al256(W_YBUF + (size_t)TT * 256 * 4);
constexpr size_t W_PM = al256(W_PO + (size_t)1024 * 32 * 64 * 4);
constexpr size_t W_PL = al256(W_PM + (size_t)1024 * 32 * 4);
constexpr size_t W_YS = al256(W_PL + (size_t)1024 * 32 * 4);
constexpr size_t W_X2 = al256(W_YS + (size_t)11 * TS * DM * 4);
constexpr size_t W_XB16 = al256(W_X2 + (size_t)TT * DM * 4);
constexpr size_t W_HS16 = al256(W_XB16 + (size_t)TT * 512 * 2);
constexpr size_t W_BAR = al256(W_HS16 + (size_t)256 * 32768 * 2);
constexpr size_t W_END = al256(W_BAR + (size_t)4096 * 4);

struct Params {
    const float* in[34];
    float* out;
    unsigned char* ws;
    int ph_lo, ph_hi;
};
enum { I_XP = 0, I_XS, I_CP, I_CS, I_CK, I_CV, I_CLOGF, I_SLCONV, I_SLH, I_SSCONV, I_SSH, I_WMOD, I_BMOD, I_NPRE, I_NPOST, I_WG, I_WU, I_WD, I_WIN, I_WOUT,
       I_LCW, I_LCB, I_LWA, I_LBA, I_LWX, I_LBX, I_LLAM, I_FBIAS, I_SCW, I_SCB, I_SDTB, I_SALOG, I_SD, I_SNW };

__device__ __forceinline__ int fresh_tid() { int t = threadIdx.x; asm volatile("" : "+v"(t)); return t; }
__device__ __forceinline__ unsigned cvt_pk_bf16(float lo, float hi) { unsigned r; asm volatile("v_cvt_pk_bf16_f32 %0, %1, %2" : "=v"(r) : "v"(lo), "v"(hi)); return r; }
__device__ __forceinline__ bf16_t f2bf(float f) { return (bf16_t)(cvt_pk_bf16(f, 0.f) & 0xffffu); }
__device__ __forceinline__ float wave_sum(float v) {
#pragma unroll
    for (int o = 32; o > 0; o >>= 1) v += __shfl_xor(v, o);
    return v;
}
__device__ __forceinline__ float sigmoid_f(float x) { return __builtin_amdgcn_rcpf(1.f + __expf(-x)); }
__device__ __forceinline__ float silu_f(float x) { return x * __builtin_amdgcn_rcpf(1.f + __expf(-x)); }
__device__ __forceinline__ float softplus_f(float x) { return fmaxf(x, 0.f) + log1pf(__expf(-fabsf(x))); }
__device__ __forceinline__ float logsigmoid_f(float x) { return fminf(x, 0.f) - log1pf(__expf(-fabsf(x))); }
__device__ __forceinline__ float gelu_tanh_f(float x) { const float u = 0.7978845608028654f * (x + 0.044715f * x * x * x); return x * sigmoid_f(2.f * u); }
__device__ __forceinline__ int seq_of_row(int r) { return r < TP ? (r >> 11) : 8 + ((r - TP) >> 5); }


#define XB_TMO      128
#define XB_XCNT(j)  (256  + 64 * (j))
#define XB_XSUB(j)  (1280 + 64 * (j))
#define XB_XGEN(j)  (2304 + 64 * (j))
#define XB_TOP      3328
#define XB_TOPGEN   3392
#define XCD_BAR_WORDS 3456
#define XB_SPIN_CAP (1u << 22)
__device__ __forceinline__ unsigned xb_ld(unsigned* p)              { return __hip_atomic_load(p, __ATOMIC_RELAXED, __HIP_MEMORY_SCOPE_AGENT); }
__device__ __forceinline__ unsigned xb_add(unsigned* p, unsigned v) { return __hip_atomic_fetch_add(p, v, __ATOMIC_RELAXED, __HIP_MEMORY_SCOPE_AGENT); }
__device__ __forceinline__ unsigned xb_xcc_id() { return (unsigned)__builtin_amdgcn_s_getreg((3 << 11) | 20) & 0xFu; }
#define XB_SPIN(cond, bar) do { unsigned _sp = 0; while (cond) { __builtin_amdgcn_s_sleep(1); \
    if ((++_sp & 255u) == 0u) { if (xb_ld(&(bar)[XB_TMO])) break; if (_sp > XB_SPIN_CAP) { atomicAdd(&(bar)[XB_TMO], 1u); break; } } } } while (0)
struct XcdBarrier { unsigned* bar; unsigned x; volatile LAS unsigned* st; };
__device__ __forceinline__ XcdBarrier xcd_barrier_post(unsigned* bar, volatile LAS unsigned* st) {
    XcdBarrier b; b.bar = bar; b.x = xb_xcc_id(); b.st = st;
    if (threadIdx.x == 0) (void)xb_add(&bar[XB_XCNT(b.x)], 1u);
    return b;
}
__device__ __forceinline__ void xcd_barrier_complete(unsigned* bar, unsigned x, unsigned& nloc, unsigned& nx) {
    const unsigned G = gridDim.x * gridDim.y * gridDim.z;
    unsigned sum, cnt, mine, sp = 0u;
    for (;;) {
        sum = 0u; cnt = 0u; mine = 0u;
#pragma unroll
        for (unsigned j = 0; j < 16; ++j) { const unsigned c = xb_ld(&bar[XB_XCNT(j)]); sum += c; cnt += (c > 0u) ? 1u : 0u; mine = (j == x) ? c : mine; }
        if (sum == G) break;
        __builtin_amdgcn_s_sleep(1);
        if ((++sp & 255u) == 0u) { if (xb_ld(&bar[XB_TMO])) break; if (sp > XB_SPIN_CAP) { atomicAdd(&bar[XB_TMO], 1u); break; } }
    }
    nloc = mine > 0u ? mine : 1u; nx = cnt > 0u ? cnt : 1u;
}
__device__ __forceinline__ void xcd_barrier(const XcdBarrier& b) {
    asm volatile("s_waitcnt vmcnt(0)" ::: "memory");
    __syncthreads();
    if (threadIdx.x == 0) {
        unsigned* bar = b.bar;
        __builtin_amdgcn_s_waitcnt(0);
        unsigned nloc = b.st[0], nx = b.st[1];
        if (nloc == 0u) { xcd_barrier_complete(bar, b.x, nloc, nx); b.st[0] = nloc; b.st[1] = nx; }
        const unsigned old = xb_add(&bar[XB_XSUB(b.x)], 1u);
        const unsigned gen = old / nloc;
        if (old + 1u == (gen + 1u) * nloc) {
            __builtin_amdgcn_fence(__ATOMIC_RELEASE, "agent");
            asm volatile("s_waitcnt vmcnt(0)" ::: "memory");
            const unsigned og = xb_add(&bar[XB_TOP], 1u);
            const unsigned tg = og / nx;
            if (og + 1u == (tg + 1u) * nx) xb_add(&bar[XB_TOPGEN], 1u);
            else XB_SPIN(xb_ld(&bar[XB_TOPGEN]) == tg, bar);
            __builtin_amdgcn_fence(__ATOMIC_ACQUIRE, "agent");
            xb_add(&bar[XB_XGEN(b.x)], 1u);
            asm volatile("s_waitcnt vmcnt(0)" ::: "memory");
        } else {
            XB_SPIN(xb_ld(&bar[XB_XGEN(b.x)]) == gen, bar);
            __builtin_amdgcn_fence(__ATOMIC_ACQUIRE, "agent");
            asm volatile("s_waitcnt vmcnt(0)" ::: "memory");
        }
    }
    __syncthreads();
}

struct CItem { int seq, c, L, row0, b; bool prompt, lastc; };
__device__ __forceinline__ CItem citem(int ci) {
    CItem it;
    if (ci < 256) { it.prompt = true; it.seq = ci >> 5; it.c = ci & 31; it.L = 64; it.row0 = it.seq * 2048 + it.c * 64; it.b = it.seq; it.lastc = (it.c == 31); }
    else { it.prompt = false; it.b = ci - 256; it.seq = 8 + it.b; it.c = 0; it.L = 32; it.row0 = TP + it.b * 32; it.lastc = true; }
    return it;
}

namespace pg8 {
constexpr int BM = 256, BK = 64, HALF = 128, HTB = HALF * BK * 2, STAGE_BYTES = 8 * HTB, NXCD = 8, WGM = 8;
__device__ __forceinline__ int lds_byte(int r, int c) { const int st = (r >> 4) * 2 + (c >> 5), rr = r & 15, cc = c & 31, ob = rr * 64 + cc * 2; return st * 1024 + (ob ^ (((ob >> 9) & 1) << 5)); }
__device__ __forceinline__ void stage_rc(int b, int& R, int& C) { const int st = b / 1024, sb = b % 1024, swz = sb ^ (((sb >> 9) & 1) << 5); R = (st >> 1) * 16 + swz / 64; C = (st & 1) * 32 + (swz % 64) / 2; }
__device__ __forceinline__ int perm32(int rho) { const int n = rho >> 4, i = rho & 15; return 8 * (i >> 2) + 4 * n + (i & 3); }
struct Unit { int pm, pn, k0, nt, slab; };
struct Gemm { const bf16_t* A; const bf16_t* Bt; int lda, ldb; };
struct StaticOrder {
    int nM, nN, nwg, G, c, ntk;
    __device__ void init(int M, int N, int K, int G_, int c_) { nM = M / BM; nN = N / BM; nwg = nM * nN; G = G_; c = c_; ntk = K / BK; }
    __device__ bool next(int i, Unit& u) const {
        const long L = (long)i * G + c; if (L >= nwg) return false;
        int wgid = (int)L; { const int q = nwg / NXCD, r = nwg % NXCD, xcd = wgid % NXCD, off = wgid / NXCD; wgid = (xcd < r ? xcd * (q + 1) : r * (q + 1) + (xcd - r) * q) + off; }
        const int nig = WGM * nN, gid = wgid / nig, fm = gid * WGM, gsz = (nM - fm) < WGM ? (nM - fm) : WGM;
        u.pm = fm + ((wgid % nig) % gsz); u.pn = (wgid % nig) / gsz; u.k0 = 0; u.nt = ntk; u.slab = 0; return true;
    }
    __device__ __forceinline__ void a_ready(const Unit&) const {}
    __device__ __forceinline__ void done(const Unit&) const {}
};

struct SampleSplitOrder {
    StaticOrder P; int nslice;
    __device__ void init(int N, int K, int G_, int c_) { P.init(TP, N, K, G_, c_); nslice = K / 256; }
    __device__ bool next(int i, Unit& u) const {
        const long L = (long)i * P.G + P.c;
        if (L < P.nwg) return P.next(i, u);
        const int e = (int)(L - P.nwg); if (e >= 2 * P.nN * nslice) return false;
        const int tile = e / nslice, s = e % nslice; u.pm = 64 + tile / P.nN; u.pn = tile % P.nN; u.k0 = s * 256; u.nt = 4; u.slab = s; return true;
    }
    __device__ __forceinline__ void a_ready(const Unit&) const {}
    __device__ __forceinline__ void done(const Unit&) const {}
};

struct EpiF32 {
    static constexpr bool PERM = false;
    float* C; float* S; int ldc;
    __device__ __forceinline__ void operator()(const f32x4 (&acc)[2][2][4][2], const Unit& u, int wr, int wc, int fr, int fq) const {
        const int row0 = u.pm * BM + wr * 64 + fr, col0 = u.pn * BM + wc * 32 + 4 * fq;
        float* base = u.pm >= 64 ? S + ((long)u.slab * TS - TP) * (long)ldc : C;
#pragma unroll
        for (int ai = 0; ai < 2; ++ai)
#pragma unroll
            for (int m = 0; m < 4; ++m) { float* rowp = base + (size_t)(row0 + ai * HALF + m * 16) * ldc + col0;
#pragma unroll
                for (int bj = 0; bj < 2; ++bj)
#pragma unroll
                    for (int n = 0; n < 2; ++n) *(f32x4*)(rowp + bj * HALF + n * 16) = acc[ai][bj][m][n]; }
    }
};
struct EpiY {
    static constexpr bool PERM = true;
    bf16_t* C; float* S;
    __device__ __forceinline__ void operator()(const f32x4 (&acc)[2][2][4][2], const Unit& u, int wr, int wc, int fr, int fq) const {
        const int row0 = u.pm * BM + wr * 64 + fr, col0 = u.pn * BM + wc * 32 + 8 * fq;
        if (u.pm < 64) {
#pragma unroll
            for (int ai = 0; ai < 2; ++ai)
#pragma unroll
                for (int m = 0; m < 4; ++m) { bf16_t* rowp = C + (size_t)(row0 + ai * HALF + m * 16) * DM + col0;
#pragma unroll
                    for (int bj = 0; bj < 2; ++bj) { const f32x4 v0 = acc[ai][bj][m][0], v1 = acc[ai][bj][m][1];
                        u32x4 w; w.x = cvt_pk_bf16(v0[0], v0[1]); w.y = cvt_pk_bf16(v0[2], v0[3]); w.z = cvt_pk_bf16(v1[0], v1[1]); w.w = cvt_pk_bf16(v1[2], v1[3]);
                        *(u32x4*)(rowp + bj * HALF) = w; } }
        } else {
            float* base = S + ((long)u.slab * TS - TP) * (long)DM;
#pragma unroll
            for (int ai = 0; ai < 2; ++ai)
#pragma unroll
                for (int m = 0; m < 4; ++m) { float* rowp = base + (size_t)(row0 + ai * HALF + m * 16) * DM + col0;
#pragma unroll
                    for (int bj = 0; bj < 2; ++bj) { *(f32x4*)(rowp + bj * HALF) = acc[ai][bj][m][0]; *(f32x4*)(rowp + bj * HALF + 4) = acc[ai][bj][m][1]; } }
        }
    }
};
struct EpiGU {
    static constexpr bool PERM = true;
    bf16_t* O;
    __device__ __forceinline__ void operator()(const f32x4 (&acc)[2][2][4][2], const Unit& u, int wr, int wc, int fr, int fq) const {
        const int row0 = u.pm * BM + wr * 64 + fr, col0 = u.pn * HALF + wc * 32 + 8 * fq;
#pragma unroll
        for (int ai = 0; ai < 2; ++ai)
#pragma unroll
            for (int m = 0; m < 4; ++m) { bf16_t* rowp = O + (size_t)(row0 + ai * HALF + m * 16) * DFF + col0;
                float v[8];
#pragma unroll
                for (int n = 0; n < 2; ++n)
#pragma unroll
                    for (int j = 0; j < 4; ++j) { const float gt = acc[ai][0][m][n][j], up = acc[ai][1][m][n][j]; v[n * 4 + j] = silu_f(gt) * up; }
                u32x4 w; w.x = cvt_pk_bf16(v[0], v[1]); w.y = cvt_pk_bf16(v[2], v[3]); w.z = cvt_pk_bf16(v[4], v[5]); w.w = cvt_pk_bf16(v[6], v[7]);
                *(u32x4*)rowp = w; }
    }
};
struct EpiIn {
    static constexpr bool PERM = false;
    float* proj; bf16_t* qb; bf16_t* kb; bf16_t* vb; float* kp; float* ks; float* vp; float* vs;
    __device__ __forceinline__ void operator()(const f32x4 (&acc)[2][2][4][2], const Unit& u, int wr, int wc, int fr, int fq) const {
        const int row0 = u.pm * BM + wr * 64 + fr; const int pn = u.pn;
        if (pn < 2 || pn >= 8) {
            const int col0 = pn * BM + wc * 32 + 4 * fq;
#pragma unroll
            for (int ai = 0; ai < 2; ++ai)
#pragma unroll
                for (int m = 0; m < 4; ++m) { float* rowp = proj + (size_t)(row0 + ai * HALF + m * 16) * NIN + col0;
#pragma unroll
                    for (int bj = 0; bj < 2; ++bj)
#pragma unroll
                        for (int n = 0; n < 2; ++n) *(f32x4*)(rowp + bj * HALF + n * 16) = acc[ai][bj][m][n]; }
        } else if (pn < 4) {
            const int col0 = (pn - 2) * BM + wc * 32 + 4 * fq;
#pragma unroll
            for (int ai = 0; ai < 2; ++ai)
#pragma unroll
                for (int m = 0; m < 4; ++m) { bf16_t* rowp = qb + (size_t)(row0 + ai * HALF + m * 16) * 512 + col0;
#pragma unroll
                    for (int bj = 0; bj < 2; ++bj)
#pragma unroll
                        for (int n = 0; n < 2; ++n) { const f32x4 a = acc[ai][bj][m][n]; u32x2 w; w.x = cvt_pk_bf16(a[0], a[1]); w.y = cvt_pk_bf16(a[2], a[3]); *(u32x2*)(rowp + bj * HALF + n * 16) = w; } }
        } else {
            const bool isk = pn < 6; const int col0 = ((pn - 4) & 1) * BM + wc * 32 + 4 * fq;
            bf16_t* bb = isk ? kb : vb; float* fp = isk ? kp : vp; float* fs = isk ? ks : vs;
#pragma unroll
            for (int ai = 0; ai < 2; ++ai)
#pragma unroll
                for (int m = 0; m < 4; ++m) { const int row = row0 + ai * HALF + m * 16;
                    bf16_t* rowp = bb + (size_t)row * 512 + col0;
                    float* rowf = (row < TP ? fp + (size_t)row * 512 : fs + (size_t)(row - TP) * 512) + col0;
#pragma unroll
                    for (int bj = 0; bj < 2; ++bj)
#pragma unroll
                        for (int n = 0; n < 2; ++n) { const f32x4 a = acc[ai][bj][m][n]; u32x2 w; w.x = cvt_pk_bf16(a[0], a[1]); w.y = cvt_pk_bf16(a[2], a[3]);
                            *(u32x2*)(rowp + bj * HALF + n * 16) = w; *(f32x4*)(rowf + bj * HALF + n * 16) = a; } }
        }
    }
};

template <class Epi, class Sched>
__device__ __forceinline__ void gemm_phase(LAS unsigned char* lds, const Gemm g, const Sched& S, const Epi& E) {
    const int tid = fresh_tid(), wid = __builtin_amdgcn_readfirstlane(tid >> 6), lane = tid & 63, wr = wid >> 2, wc = wid & 3, fr = lane & 15, fq = lane >> 4;
    const int lda = g.lda, ldb = g.ldb;
    unsigned voffA[2], voffB[2];
#pragma unroll
    for (int i = 0; i < 2; ++i) { int R, C; stage_rc(tid * 16 + i * 8192, R, C); const int Rb = Epi::PERM ? ((R & ~31) + perm32(R & 31)) : R;
        voffA[i] = (unsigned)(R * lda + C) * 2u; voffB[i] = (unsigned)(Rb * ldb + C) * 2u; }
    const size_t kstep = (size_t)(BK * 2);
    const size_t hstepA = (size_t)HALF * lda * 2, hstepB = (size_t)HALF * ldb * 2;
    const size_t tstepA = 2 * hstepA, tstepB = 2 * hstepB;
    const unsigned ldsw = (unsigned)wid * 1024u;
    const int aoff = lds_byte(wr * 64 + fr, fq * 8), boff = lds_byte(wc * 32 + fr, fq * 8);
#define PG8_SA(b, h) (((b) * 2 + (h)) * HTB)
#define PG8_SB(b, h) ((4 + (b) * 2 + (h)) * HTB)
#define PG8_STAGE(bufoff, gbase, voff) do { _Pragma("unroll") for (int _i = 0; _i < 2; ++_i) \
        __builtin_amdgcn_global_load_lds((const unsigned*)((const char*)(gbase) + (voff)[_i]), (LAS unsigned*)(lds + (bufoff) + ldsw + _i * 8192), 16, 0, 0); } while (0)
#define PG8_LDA(dst, b, h) do { _Pragma("unroll") for (int m = 0; m < 4; ++m) _Pragma("unroll") for (int k = 0; k < 2; ++k) dst[m][k] = *(const LAS bf16x8*)(lds + PG8_SA(b, h) + aoff + m * 2048 + k * 1024); } while (0)
#define PG8_LDB(dst, b, h) do { _Pragma("unroll") for (int n = 0; n < 2; ++n) _Pragma("unroll") for (int k = 0; k < 2; ++k) dst[n][k] = *(const LAS bf16x8*)(lds + PG8_SB(b, h) + boff + n * 2048 + k * 1024); } while (0)
#define PG8_MMA(ai, bj, At, Bt) do { __builtin_amdgcn_s_setprio(1); _Pragma("unroll") for (int m = 0; m < 4; ++m) _Pragma("unroll") for (int n = 0; n < 2; ++n) _Pragma("unroll") for (int k = 0; k < 2; ++k) \
        acc[ai][bj][m][n] = __builtin_amdgcn_mfma_f32_16x16x32_bf16(Bt[n][k], At[m][k], acc[ai][bj][m][n], 0, 0, 0); __builtin_amdgcn_s_setprio(0); } while (0)
#define PG8_WAIT_V(n) asm volatile("s_waitcnt vmcnt(" #n ")" ::: "memory")
#define PG8_WAIT_L(n) asm volatile("s_waitcnt lgkmcnt(" #n ")" ::: "memory")
#define PG8_BAR __builtin_amdgcn_s_barrier()
#define PG8_SCHED __builtin_amdgcn_sched_barrier(0)
    Unit cur, nxt; int ui = 0;
    if (!S.next(0, cur)) return;
    f32x4 acc[2][2][4][2];
#pragma unroll
    for (int a = 0; a < 2; ++a)
#pragma unroll
        for (int b = 0; b < 2; ++b)
#pragma unroll
            for (int m = 0; m < 4; ++m)
#pragma unroll
                for (int n = 0; n < 2; ++n) acc[a][b][m][n] = (f32x4){0.f, 0.f, 0.f, 0.f};
    bf16x8 At[4][2], B0[2][2], B1[2][2];
    const char* cA = (const char*)g.A + (size_t)cur.pm * tstepA + (size_t)cur.k0 * 2; const char* cB = (const char*)g.Bt + (size_t)cur.pn * tstepB + (size_t)cur.k0 * 2;
    S.a_ready(cur);
    PG8_STAGE(PG8_SB(0, 0), cB, voffB); PG8_STAGE(PG8_SA(0, 0), cA, voffA); PG8_STAGE(PG8_SB(0, 1), cB + hstepB, voffB); PG8_STAGE(PG8_SA(0, 1), cA + hstepA, voffA);
    if (wr == 1) PG8_BAR;
    PG8_WAIT_V(4); PG8_BAR;
    PG8_STAGE(PG8_SB(1, 0), cB + kstep, voffB); PG8_STAGE(PG8_SA(1, 0), cA + kstep, voffA); PG8_STAGE(PG8_SB(1, 1), cB + hstepB + kstep, voffB);
    PG8_WAIT_V(6); PG8_BAR;
    for (;;) {
        const bool has_next = S.next(ui + 1, nxt);
        const char* nA = has_next ? (const char*)g.A + (size_t)nxt.pm * tstepA + (size_t)nxt.k0 * 2 : cA; const char* nB = has_next ? (const char*)g.Bt + (size_t)nxt.pn * tstepB + (size_t)nxt.k0 * 2 : cB;
        const int nt = cur.nt;
        for (int t = 0; t < nt; t += 2) {
            const bool last = (t == nt - 2);
            const char* a1 = cA + (size_t)(t + 1) * kstep;
            const char* a2 = last ? nA : cA + (size_t)(t + 2) * kstep; const char* b2 = last ? nB : cB + (size_t)(t + 2) * kstep;
            const char* a3 = a2 + kstep; const char* b3 = b2 + kstep;
            if (last && has_next) S.a_ready(nxt);
            PG8_LDB(B0, 0, 0); PG8_SCHED; PG8_LDA(At, 0, 0); PG8_STAGE(PG8_SA(1, 1), a1 + hstepA, voffA);
            PG8_WAIT_L(8); PG8_BAR; PG8_WAIT_L(0); PG8_MMA(0, 0, At, B0); PG8_BAR; PG8_SCHED;
            PG8_LDB(B1, 0, 1); PG8_STAGE(PG8_SB(0, 0), b2, voffB);
            PG8_BAR; PG8_WAIT_L(0); PG8_MMA(0, 1, At, B1); PG8_BAR;
            PG8_LDA(At, 0, 1); PG8_STAGE(PG8_SA(0, 0), a2, voffA);
            PG8_BAR; PG8_WAIT_L(0); PG8_MMA(1, 0, At, B0); PG8_BAR; PG8_SCHED;
            PG8_STAGE(PG8_SB(0, 1), b2 + hstepB, voffB);
            PG8_WAIT_V(6); PG8_BAR; PG8_MMA(1, 1, At, B1); PG8_BAR;
            PG8_LDB(B0, 1, 0); PG8_SCHED; PG8_LDA(At, 1, 0); PG8_STAGE(PG8_SA(0, 1), a2 + hstepA, voffA);
            PG8_WAIT_L(8); PG8_BAR; PG8_WAIT_L(0); PG8_MMA(0, 0, At, B0); PG8_BAR; PG8_SCHED;
            PG8_LDB(B1, 1, 1); PG8_STAGE(PG8_SB(1, 0), b3, voffB);
            PG8_BAR; PG8_WAIT_L(0); PG8_MMA(0, 1, At, B1); PG8_BAR;
            PG8_LDA(At, 1, 1); PG8_STAGE(PG8_SA(1, 0), a3, voffA);
            PG8_BAR; PG8_WAIT_L(0); PG8_MMA(1, 0, At, B0); PG8_BAR; PG8_SCHED;
            PG8_STAGE(PG8_SB(1, 1), b3 + hstepB, voffB);
            PG8_WAIT_V(6); PG8_BAR; PG8_MMA(1, 1, At, B1); PG8_BAR;
        }
        E(acc, cur, wr, wc, fr, fq); S.done(cur);
        if (!has_next) break;
#pragma unroll
        for (int a = 0; a < 2; ++a)
#pragma unroll
            for (int b = 0; b < 2; ++b)
#pragma unroll
                for (int m = 0; m < 4; ++m)
#pragma unroll
                    for (int n = 0; n < 2; ++n) acc[a][b][m][n] = (f32x4){0.f, 0.f, 0.f, 0.f};
        cur = nxt; cA = nA; cB = nB; ++ui;
    }
    PG8_WAIT_V(0);
    if (wr == 0) PG8_BAR;
    PG8_BAR;
#undef PG8_SA
#undef PG8_SB
#undef PG8_STAGE
#undef PG8_LDA
#undef PG8_LDB
#undef PG8_MMA
#undef PG8_WAIT_V
#undef PG8_WAIT_L
#undef PG8_BAR
#undef PG8_SCHED
}
}

constexpr int NTR_GU = 4 * 88 * 4, NTR_D = 4 * 16 * 11, NTR_IN = 2 * 52 * 4, NTR_OUT = 2 * 16 * 4, NTR = NTR_GU + NTR_D + NTR_IN + NTR_OUT;
constexpr int WT_D = NTR_GU, WT_IN = NTR_GU + NTR_D, WT_OUT = NTR_GU + NTR_D + NTR_IN;
__device__ __forceinline__ void wtile(const Params& p, LAS float* fl, int tid, int tr) {
            const float* src; bf16_t* dst; int K, ldsrc, ntile, kt;
            const int n4 = (tid & 15) * 4, kr = tid >> 4;
            if (tr < NTR_GU) { const int lf = tr / 352, rem = tr % 352; ntile = rem / 4; kt = rem % 4; dst = (bf16_t*)(p.ws + W_GU) + (size_t)lf * NGU * DM; K = DM; ldsrc = DFF;
                const int np = ntile * 64 + n4; const int col = (np >> 8) * 128 + (np & 127); src = ((np >> 7) & 1 ? p.in[I_WU] : p.in[I_WG]) + (size_t)lf * DM * DFF + col; }
            else if (tr < NTR_GU + NTR_D) { tr -= NTR_GU; const int lf = tr / 176, rem = tr % 176; ntile = rem / 11; kt = rem % 11; dst = (bf16_t*)(p.ws + W_D) + (size_t)lf * DM * DFF; K = DFF; ldsrc = DM;
                src = p.in[I_WD] + (size_t)lf * DFF * DM + ntile * 64 + n4; }
            else if (tr < NTR_GU + NTR_D + NTR_IN) { tr -= NTR_GU + NTR_D; const int l = tr / 208, rem = tr % 208; ntile = rem / 4; kt = rem % 4; dst = (bf16_t*)(p.ws + W_IN) + (size_t)l * NIN * DM; K = DM; ldsrc = DIN;
                const int np = ntile * 64 + n4; const int col = np < 2048 ? np : (np < 3072 ? np + 8 : (np < 3080 ? np - 1024 : (np < 3084 ? np : -1)));
                src = col >= 0 ? p.in[I_WIN] + (size_t)l * DM * DIN + col : nullptr; }
            else { tr -= NTR_GU + NTR_D + NTR_IN; const int l = tr / 64, rem = tr % 64; ntile = rem / 4; kt = rem % 4; dst = (bf16_t*)(p.ws + W_OUT) + (size_t)l * DM * DM; K = DM; ldsrc = DM;
                src = p.in[I_WOUT] + (size_t)l * DM * DM + ntile * 64 + n4; }
            const int k0 = kt * 256;
            f32x4 v[8];
            const float* sb = src ? src + (size_t)(k0 + kr) * ldsrc : nullptr;
#pragma unroll
            for (int i = 0; i < 8; ++i) v[i] = sb ? *(const f32x4*)(sb + (size_t)(32 * i) * ldsrc) : (f32x4){0.f, 0.f, 0.f, 0.f};
#pragma unroll
            for (int i = 0; i < 8; ++i) { LAS float* d = fl + (kr + 32 * i) * 65 + n4; d[0] = v[i][0]; d[1] = v[i][1]; d[2] = v[i][2]; d[3] = v[i][3]; }
            __syncthreads();
            const int nl = tid >> 3;
#pragma unroll
            for (int r = 0; r < 4; ++r) { const int kseg = (tid & 7) * 8 + r * 64; float o[8];
#pragma unroll
                for (int j = 0; j < 8; ++j) o[j] = fl[(kseg + j) * 65 + nl];
                u32x4 w; w.x = cvt_pk_bf16(o[0], o[1]); w.y = cvt_pk_bf16(o[2], o[3]); w.z = cvt_pk_bf16(o[4], o[5]); w.w = cvt_pk_bf16(o[6], o[7]);
                *(u32x4*)(dst + (size_t)(ntile * 64 + nl) * K + k0 + kseg) = w; }
            __syncthreads();
}
__device__ __forceinline__ void wconv(const Params& p, LAS unsigned char* lds, int lo0, int n0, int lo1, int n1, int lo2, int n2, int rel, int stride) {
    const int tid = fresh_tid();
    for (int v = rel; v < n0 + n1 + n2; v += stride) { const int tr = v < n0 ? lo0 + v : (v < n0 + n1 ? lo1 + (v - n0) : lo2 + (v - n0 - n1)); wtile(p, (LAS float*)lds, tid, tr); }
}
__device__ __forceinline__ void prep_phase(const Params& p, LAS unsigned char* lds, int bid, int nb) {
    const int tid = fresh_tid();
    LAS float* fl = (LAS float*)lds;
    bool sc_ready = false;
    for (int it = bid; it < 320 + 352; it += nb) {
        if (it < 288) {
            LAS float* sc = fl; LAS float* red = fl + 24 * 1024;
            if (!sc_ready) {
                for (int i = tid; i < 24 * 1024; i += 512) { const int s = i >> 10, k = i & 1023; const float c = s < 8 ? p.in[I_CP][s * 1024 + k] : p.in[I_CS][(s - 8) * 1024 + k]; sc[i] = silu_f(c); }
                __syncthreads(); sc_ready = true;
            }
            const int l = it / 144, c0 = (it % 144) * 64, cq = (tid & 15) * 4, kg = tid >> 4;
            f32x4 acc[24];
#pragma unroll
            for (int s = 0; s < 24; ++s) acc[s] = (f32x4){0.f, 0.f, 0.f, 0.f};
            const float* w = p.in[I_WMOD] + (size_t)l * 1024 * 9216 + c0 + cq + (size_t)(kg * 32) * 9216;
#pragma unroll 1
            for (int kb = 0; kb < 32; kb += 8) {
                f32x4 wv[8];
#pragma unroll
                for (int i = 0; i < 8; ++i) wv[i] = *(const f32x4*)(w + (size_t)(kb + i) * 9216);
#pragma unroll
                for (int i = 0; i < 8; i += 4) {
#pragma unroll
                    for (int s = 0; s < 24; ++s) { const f32x4 c4 = *(const LAS f32x4*)(sc + s * 1024 + kg * 32 + kb + i); acc[s] += c4[0] * wv[i] + c4[1] * wv[i + 1] + c4[2] * wv[i + 2] + c4[3] * wv[i + 3]; } }
            }
#pragma unroll
            for (int s = 0; s < 24; ++s) {
#pragma unroll
                for (int c = 0; c < 4; ++c) { float a = acc[s][c]; a += __shfl_xor(a, 16); a += __shfl_xor(a, 32); acc[s][c] = a; } }
            if ((tid & 63) < 16) { const int wv8 = tid >> 6;
#pragma unroll
                for (int s = 0; s < 24; ++s) *(LAS f32x4*)(red + (wv8 * 24 + s) * 64 + cq) = acc[s]; }
            __syncthreads();
            float* mod = (float*)(p.ws + W_MOD);
            for (int i = tid; i < 24 * 64; i += 512) { const int s = i >> 6, cc = i & 63; float sum = p.in[I_BMOD][l * 9216 + c0 + cc];
                for (int k2 = 0; k2 < 8; ++k2) sum += red[(k2 * 24 + s) * 64 + cc];
                mod[(size_t)(l * 24 + s) * 9216 + c0 + cc] = sum; }
            __syncthreads();
        } else if (it < 320) {
            const int idx = it - 288;
            const float* base = p.in[I_CLOGF] + (size_t)idx * 4096 * 8; float* fc = (float*)(p.ws + W_FC) + (size_t)idx * 4096 * 8;
            const int head = tid & 7, seg = tid >> 3;
            const float* bp = base + (seg * 64) * 8 + head; float* fp = fc + (seg * 64) * 8 + head;
            float run = 0.f;
            for (int i0 = 0; i0 < 64; i0 += 16) { float v[16];
#pragma unroll
                for (int i = 0; i < 16; ++i) v[i] = bp[(i0 + i) * 8];
#pragma unroll
                for (int i = 0; i < 16; ++i) { run += v[i]; fp[(i0 + i) * 8] = run; } }
            __syncthreads();
            fl[seg * 8 + head] = run;
            __syncthreads();
            float off = 0.f; for (int s2 = 0; s2 < seg; ++s2) off += fl[s2 * 8 + head];
            for (int i0 = 0; i0 < 64; i0 += 16) { float v[16];
#pragma unroll
                for (int i = 0; i < 16; ++i) v[i] = fp[(i0 + i) * 8];
#pragma unroll
                for (int i = 0; i < 16; ++i) fp[(i0 + i) * 8] = v[i] + off; }
            __syncthreads();
        } else {
            wtile(p, fl, tid, it - 320);
        }
    }
}

__device__ __forceinline__ void norm_phase(const Params& p, bool first, bool last, int lpost, int jpost, float wpost, int lpre, int jpre, int nslab, int xsel, int bid, int nb) {
    const int tid = fresh_tid(), wave = tid >> 6, lane = tid & 63;
    const bf16_t* xrd = (const bf16_t*)(p.ws + (xsel ? W_X2 : W_X)); bf16_t* xws = (bf16_t*)(p.ws + (xsel ? W_X : W_X2));
    const bf16_t* Y = (const bf16_t*)(p.ws + W_Y); bf16_t* H = (bf16_t*)(p.ws + W_H); const float* mod = (const float*)(p.ws + W_MOD);
    for (int pass = 0; pass < 2; ++pass) {
        const int cstart = pass == 0 ? (bid * 8 + wave) * 8 : (wave < 2 ? TP + bid * 2 + wave : TT), cstride = pass == 0 ? nb * 64 : nb * 2, climit = pass == 0 ? TP : TT, nrow = pass == 0 ? 8 : 1;
        for (int rbase = cstart; rbase < climit; rbase += cstride) {
        const int seq = seq_of_row(rbase);
        f32x4 Av[4], Bv[4], Cv[4];
        if (!first) { const float* gate = mod + (size_t)(lpost * 24 + seq) * 9216 + jpost * 3072 + 2048; const float* gp = p.in[I_NPOST] + (lpost * 3 + jpost) * DM;
#pragma unroll
            for (int i = 0; i < 4; ++i) Av[i] = wpost * (*(const f32x4*)(gate + lane * 4 + i * 256)) * (*(const f32x4*)(gp + lane * 4 + i * 256)); }
        if (!last) { const float* mq = mod + (size_t)(lpre * 24 + seq) * 9216 + jpre * 3072; const float* gp = p.in[I_NPRE] + (lpre * 3 + jpre) * DM;
#pragma unroll
            for (int i = 0; i < 4; ++i) { const int col = lane * 4 + i * 256; Bv[i] = (*(const f32x4*)(gp + col)) * (1.f + *(const f32x4*)(mq + 1024 + col)); Cv[i] = *(const f32x4*)(mq + col); } }
        for (int rp = 0; rp < nrow; rp += 2) {
            const int nr = nrow - rp >= 2 ? 2 : 1;
            f32x4 xv[2][4], yv[2][4];
#pragma unroll
            for (int r = 0; r < 2; ++r) { if (r < nr) { const int row = rbase + rp + r;
                if (first) { const float* xin = row < TP ? p.in[I_XP] + (size_t)row * DM : p.in[I_XS] + (size_t)(row - TP) * DM;
#pragma unroll
                    for (int i = 0; i < 4; ++i) xv[r][i] = *(const f32x4*)(xin + lane * 4 + i * 256);
                } else {
#pragma unroll
                    for (int i = 0; i < 4; ++i) { const u32x2 w = *(const u32x2*)(xrd + (size_t)row * DM + lane * 4 + i * 256);
                        xv[r][i] = (f32x4){__uint_as_float(w.x << 16), __uint_as_float(w.x & 0xffff0000u), __uint_as_float(w.y << 16), __uint_as_float(w.y & 0xffff0000u)}; }
                    if (row < TP) {
#pragma unroll
                        for (int i = 0; i < 4; ++i) { const u32x2 w = *(const u32x2*)(Y + (size_t)row * DM + lane * 4 + i * 256);
                            yv[r][i] = (f32x4){__uint_as_float(w.x << 16), __uint_as_float(w.x & 0xffff0000u), __uint_as_float(w.y << 16), __uint_as_float(w.y & 0xffff0000u)}; }
                    } else {
                        const float* ys = (const float*)(p.ws + W_YS) + (size_t)(row - TP) * DM + lane * 4;
#pragma unroll
                        for (int i = 0; i < 4; ++i) yv[r][i] = *(const f32x4*)(ys + i * 256);
                        for (int s = 1; s < nslab; ++s) {
#pragma unroll
                            for (int i = 0; i < 4; ++i) yv[r][i] += *(const f32x4*)(ys + (size_t)s * TS * DM + i * 256); }
                    } } } }
#pragma unroll
            for (int r = 0; r < 2; ++r) { if (r < nr) { const int row = rbase + rp + r;
                if (!first) {
                    float ssq = 0.f;
#pragma unroll
                    for (int i = 0; i < 4; ++i) ssq += yv[r][i][0] * yv[r][i][0] + yv[r][i][1] * yv[r][i][1] + yv[r][i][2] * yv[r][i][2] + yv[r][i][3] * yv[r][i][3];
                    ssq = wave_sum(ssq);
                    const float ry = rsqrtf(ssq * (1.f / DM) + EPS);
#pragma unroll
                    for (int i = 0; i < 4; ++i) xv[r][i] += Av[i] * (yv[r][i] * ry);
                }
                if (last) {
#pragma unroll
                    for (int i = 0; i < 4; ++i) *(f32x4*)(p.out + O_Y + (size_t)row * DM + lane * 4 + i * 256) = xv[r][i];
                } else {
#pragma unroll
                    for (int i = 0; i < 4; ++i) { u32x2 w; w.x = cvt_pk_bf16(xv[r][i][0], xv[r][i][1]); w.y = cvt_pk_bf16(xv[r][i][2], xv[r][i][3]); *(u32x2*)(xws + (size_t)row * DM + lane * 4 + i * 256) = w; }
                    float ssq = 0.f;
#pragma unroll
                    for (int i = 0; i < 4; ++i) ssq += xv[r][i][0] * xv[r][i][0] + xv[r][i][1] * xv[r][i][1] + xv[r][i][2] * xv[r][i][2] + xv[r][i][3] * xv[r][i][3];
                    ssq = wave_sum(ssq);
                    const float rx = rsqrtf(ssq * (1.f / DM) + EPS);
#pragma unroll
                    for (int i = 0; i < 4; ++i) { const f32x4 hv = (xv[r][i] * rx) * Bv[i] + Cv[i];
                        u32x2 w; w.x = cvt_pk_bf16(hv[0], hv[1]); w.y = cvt_pk_bf16(hv[2], hv[3]);
                        *(u32x2*)(H + (size_t)row * DM + lane * 4 + i * 256) = w; }
                }
            } }
        }
        }
    }
}

__device__ __forceinline__ void attn_prompt_item(const Params& p, int l, int item, LAS unsigned char* lds) {
    const int tid = fresh_tid(), wave = tid >> 6, lane = tid & 63, g = lane >> 4, li = lane & 15;
    const int b = item >> 5, h = (item >> 2) & 7, pr = item & 3;
    constexpr int STG = 128 * 72 + 64 * 136;
    LAS bf16_t* KV = (LAS bf16_t*)lds;
    LAS float* Fs = (LAS float*)(lds + 2 * STG * 2); LAS float* wtot = Fs + 2048;
    const float* proj = (const float*)(p.ws + W_PROJ);
    const bf16_t* qbuf = (const bf16_t*)(p.ws + W_QB); const bf16_t* kbuf = (const bf16_t*)(p.ws + W_KB); const bf16_t* vbuf = (const bf16_t*)(p.ws + W_VB);
    bf16_t* mixed = (bf16_t*)(p.ws + W_MIX);
    const float LOG2E = 1.4426950408889634f;
    __syncthreads();
    {
        const float fb = p.in[I_FBIAS][l * 8 + h]; float v[4];
#pragma unroll
        for (int i = 0; i < 4; ++i) v[i] = logsigmoid_f(proj[(size_t)(b * 2048 + tid * 4 + i) * NIN + 3072 + h] + fb);
        v[1] += v[0]; v[2] += v[1]; v[3] += v[2];
        float inc = v[3];
#pragma unroll
        for (int o = 1; o < 64; o <<= 1) { const float n = __shfl_up(inc, o); if (lane >= o) inc += n; }
        if (lane == 63) wtot[wave] = inc;
        __syncthreads();
        float woff = 0.f; for (int w2 = 0; w2 < wave; ++w2) woff += wtot[w2];
        const float ex = inc - v[3] + woff;
#pragma unroll
        for (int i = 0; i < 4; ++i) Fs[tid * 4 + i] = -(v[i] + ex) * LOG2E;
        __syncthreads();
    }
    const int ldkey = tid >> 3, lddseg = (tid & 7) * 8;
    for (int half = 0; half < 2; ++half) {
        const int qt = half == 0 ? (7 - pr) : pr;
        const int q0 = qt * 256 + wave * 32;
        bf16x8 qf[2][2];
#pragma unroll
        for (int qb = 0; qb < 2; ++qb)
#pragma unroll
            for (int ks = 0; ks < 2; ++ks) qf[qb][ks] = *(const bf16x8*)(qbuf + (size_t)(b * 2048 + q0 + qb * 16 + li) * 512 + h * 64 + ks * 32 + g * 8);
        float mrun[2] = {-1e30f, -1e30f}, lsum[2] = {0.f, 0.f};
        f32x4 ot[2][4];
#pragma unroll
        for (int qb = 0; qb < 2; ++qb)
#pragma unroll
            for (int db = 0; db < 4; ++db) ot[qb][db] = (f32x4){0.f, 0.f, 0.f, 0.f};
        const int nks = (qt + 1) * 2;
        const size_t ro0 = (size_t)(b * 2048 + ldkey) * 512 + h * 64 + lddseg;
        u32x4 kv0 = *(const u32x4*)(kbuf + ro0), kv1 = *(const u32x4*)(kbuf + ro0 + 64 * 512), vv0 = *(const u32x4*)(vbuf + ro0), vv1 = *(const u32x4*)(vbuf + ro0 + 64 * 512);
#define ATP_STORE(Kn, Vn) do { *(LAS u32x4*)((Kn) + ldkey * 72 + lddseg) = kv0; *(LAS u32x4*)((Kn) + (ldkey + 64) * 72 + lddseg) = kv1; \
            _Pragma("unroll") for (int i = 0; i < 4; ++i) { (Vn)[(lddseg + 2 * i) * 136 + ldkey] = (bf16_t)(vv0[i] & 0xffffu); (Vn)[(lddseg + 2 * i + 1) * 136 + ldkey] = (bf16_t)(vv0[i] >> 16); \
                (Vn)[(lddseg + 2 * i) * 136 + 64 + ldkey] = (bf16_t)(vv1[i] & 0xffffu); (Vn)[(lddseg + 2 * i + 1) * 136 + 64 + ldkey] = (bf16_t)(vv1[i] >> 16); } } while (0)
        __syncthreads();
        ATP_STORE(KV, KV + 128 * 72);
        __syncthreads();
        for (int ks = 0; ks < nks; ++ks) {
            LAS bf16_t* Kst = KV + (ks & 1) * STG; LAS bf16_t* Vst = Kst + 128 * 72;
            if (ks + 1 < nks) { const size_t ro = ro0 + (size_t)((ks + 1) * 128) * 512; kv0 = *(const u32x4*)(kbuf + ro); kv1 = *(const u32x4*)(kbuf + ro + 64 * 512); vv0 = *(const u32x4*)(vbuf + ro); vv1 = *(const u32x4*)(vbuf + ro + 64 * 512); }
#pragma unroll
            for (int sub = 0; sub < 2; ++sub) {
            const int k0 = ks * 128 + sub * 64;
            LAS bf16_t* Ks = Kst + sub * 64 * 72; LAS bf16_t* Vt = Vst + sub * 64;
            if (k0 <= q0 + 31) {
                f32x4 st[2][4];
#pragma unroll
                for (int kb = 0; kb < 4; ++kb) {
                    const bf16x8 kf0 = *(const LAS bf16x8*)(Ks + (kb * 16 + li) * 72 + g * 8), kf1 = *(const LAS bf16x8*)(Ks + (kb * 16 + li) * 72 + 32 + g * 8);
#pragma unroll
                    for (int qb = 0; qb < 2; ++qb) { f32x4 z = (f32x4){0.f, 0.f, 0.f, 0.f};
                        z = __builtin_amdgcn_mfma_f32_16x16x32_bf16(kf0, qf[qb][0], z, 0, 0, 0);
                        st[qb][kb] = __builtin_amdgcn_mfma_f32_16x16x32_bf16(kf1, qf[qb][1], z, 0, 0, 0); }
                }
                const bool need_mask = (k0 + 63 > q0);
#pragma unroll
                for (int qb = 0; qb < 2; ++qb) {
                    const int qg = q0 + qb * 16 + li;
                    float mx = -1e30f;
                    if (need_mask) {
#pragma unroll
                        for (int kb = 0; kb < 4; ++kb) { const f32x4 fk = *(const LAS f32x4*)(Fs + k0 + kb * 16 + g * 4);
#pragma unroll
                            for (int j = 0; j < 4; ++j) { float s = st[qb][kb][j] * (0.125f * LOG2E) + fk[j]; const int kg = k0 + kb * 16 + g * 4 + j;
                                if (kg > qg) s = -1e30f; st[qb][kb][j] = s; mx = fmaxf(mx, s); } }
                    } else {
#pragma unroll
                        for (int kb = 0; kb < 4; ++kb) { const f32x4 fk = *(const LAS f32x4*)(Fs + k0 + kb * 16 + g * 4);
#pragma unroll
                            for (int j = 0; j < 4; ++j) { const float s = st[qb][kb][j] * (0.125f * LOG2E) + fk[j]; st[qb][kb][j] = s; mx = fmaxf(mx, s); } }
                    }
                    mx = fmaxf(mx, __shfl_xor(mx, 16)); mx = fmaxf(mx, __shfl_xor(mx, 32));
                    const float mn = fmaxf(mrun[qb], mx); const float alpha = __builtin_amdgcn_exp2f(mrun[qb] - mn); mrun[qb] = mn;
                    float ps = 0.f;
#pragma unroll
                    for (int kb = 0; kb < 4; ++kb)
#pragma unroll
                        for (int j = 0; j < 4; ++j) { const float pv = __builtin_amdgcn_exp2f(st[qb][kb][j] - mn); st[qb][kb][j] = pv; ps += pv; }
                    lsum[qb] = lsum[qb] * alpha + ps;
#pragma unroll
                    for (int db = 0; db < 4; ++db) ot[qb][db] *= alpha;
                }
#pragma unroll
                for (int kstep = 0; kstep < 2; ++kstep) {
                    bf16x8 pf[2];
#pragma unroll
                    for (int qb = 0; qb < 2; ++qb) { u32x4 w; w.x = cvt_pk_bf16(st[qb][2 * kstep][0], st[qb][2 * kstep][1]); w.y = cvt_pk_bf16(st[qb][2 * kstep][2], st[qb][2 * kstep][3]);
                        w.z = cvt_pk_bf16(st[qb][2 * kstep + 1][0], st[qb][2 * kstep + 1][1]); w.w = cvt_pk_bf16(st[qb][2 * kstep + 1][2], st[qb][2 * kstep + 1][3]); pf[qb] = __builtin_bit_cast(bf16x8, w); }
#pragma unroll
                    for (int db = 0; db < 4; ++db) {
                        const u32x2 va = *(const LAS u32x2*)(Vt + (db * 16 + li) * 136 + kstep * 32 + g * 4), vb2 = *(const LAS u32x2*)(Vt + (db * 16 + li) * 136 + kstep * 32 + 16 + g * 4);
                        const u32x4 vc = {va.x, va.y, vb2.x, vb2.y}; const bf16x8 vf = __builtin_bit_cast(bf16x8, vc);
#pragma unroll
                        for (int qb = 0; qb < 2; ++qb) ot[qb][db] = __builtin_amdgcn_mfma_f32_16x16x32_bf16(vf, pf[qb], ot[qb][db], 0, 0, 0);
                    }
                }
            }
            }
            if (ks + 1 < nks) { LAS bf16_t* Kn = KV + ((ks + 1) & 1) * STG; ATP_STORE(Kn, Kn + 128 * 72); }
            __syncthreads();
        }
#undef ATP_STORE
#pragma unroll
        for (int qb = 0; qb < 2; ++qb) {
            float lt = lsum[qb]; lt += __shfl_xor(lt, 16); lt += __shfl_xor(lt, 32);
            const float inv = 1.f / lt; const size_t row = (size_t)(b * 2048 + q0 + qb * 16 + li);
#pragma unroll
            for (int db = 0; db < 4; ++db) { const f32x4 o = ot[qb][db] * inv; u32x2 w; w.x = cvt_pk_bf16(o[0], o[1]); w.y = cvt_pk_bf16(o[2], o[3]);
                *(u32x2*)(mixed + row * DM + 256 + h * 64 + db * 16 + g * 4) = w; }
        }
    }
    __syncthreads();
}

__device__ __forceinline__ void attn_sample_block(const Params& p, int l, int bid, int nb, LAS unsigned char* lds) {
    const int tid = fresh_tid(), wave = tid >> 6, lane = tid & 63, g = lane >> 4, li = lane & 15;
    LAS bf16_t* Vt = (LAS bf16_t*)lds + wave * (64 * 40);
    LAS float* cmb = (LAS float*)(lds + 8 * 64 * 40 * 2);
    const float* proj = (const float*)(p.ws + W_PROJ); const bf16_t* qbuf = (const bf16_t*)(p.ws + W_QB);
    const float LOG2E = 1.4426950408889634f;
    f32x4 kr[8], vr[8]; float fkr[8];
#define ATS_ISSUE(item_, step_) do { const int _bh = (item_) >> 1, _sp = (item_) & 1, _b = _bh >> 3, _h = _bh & 7; const bool _new = (step_) == 8; \
        const int _key0 = _sp * 2048 + wave * 256 + (step_) * 32; \
        const float* _kp = _new ? p.out + O_SK + (size_t)((l * 16 + _b) * 32) * 512 + _h * 64 : p.in[I_CK] + ((size_t)(l * 16 + _b) * 4096 + _key0) * 512 + _h * 64; \
        const float* _vp = _new ? p.out + O_SV + (size_t)((l * 16 + _b) * 32) * 512 + _h * 64 : p.in[I_CV] + ((size_t)(l * 16 + _b) * 4096 + _key0) * 512 + _h * 64; \
        _Pragma("unroll") for (int kb = 0; kb < 2; ++kb) _Pragma("unroll") for (int ks = 0; ks < 2; ++ks) { const float* a = _kp + (size_t)(kb * 16 + li) * 512 + ks * 32 + g * 8; kr[(kb * 2 + ks) * 2] = __builtin_nontemporal_load((const f32x4*)a); kr[(kb * 2 + ks) * 2 + 1] = __builtin_nontemporal_load((const f32x4*)(a + 4)); } \
        _Pragma("unroll") for (int i = 0; i < 8; ++i) vr[i] = __builtin_nontemporal_load((const f32x4*)(_vp + (size_t)(i * 4 + g) * 512 + li * 4)); \
        if (!_new) { const float* _fc = (const float*)(p.ws + W_FC) + ((size_t)(l * 16 + _b) * 4096 + _key0) * 8 + _h; \
            _Pragma("unroll") for (int kb = 0; kb < 2; ++kb) _Pragma("unroll") for (int j = 0; j < 4; ++j) fkr[kb * 4 + j] = _fc[(size_t)(kb * 16 + g * 4 + j) * 8]; } \
    } while (0)
    int it = bid;
    if (it < 256) ATS_ISSUE(it, 0);
    __syncthreads();
    for (; it < 256; it += nb) {
        const int bh = it >> 1, sp = it & 1, b = bh >> 3, h = bh & 7;
        const int nst = 8 + ((sp == 1 && wave == 0) ? 1 : 0);
        const float* Fc = (const float*)(p.ws + W_FC) + (size_t)(l * 16 + b) * 4096 * 8 + h;
        float cst = lane < 32 ? logsigmoid_f(proj[(size_t)(TP + b * 32 + lane) * NIN + 3072 + h] + p.in[I_FBIAS][l * 8 + h]) : 0.f;
#pragma unroll
        for (int o = 1; o < 32; o <<= 1) { const float n = __shfl_up(cst, o); if (lane >= o) cst += n; }
        const float FcLast = Fc[4095 * 8];
        float Fq[2]; Fq[0] = (FcLast + __shfl(cst, li)) * LOG2E; Fq[1] = (FcLast + __shfl(cst, 16 + li)) * LOG2E;
        bf16x8 qf[2][2];
#pragma unroll
        for (int qb = 0; qb < 2; ++qb)
#pragma unroll
            for (int ks = 0; ks < 2; ++ks) qf[qb][ks] = *(const bf16x8*)(qbuf + (size_t)(TP + b * 32 + qb * 16 + li) * 512 + h * 64 + ks * 32 + g * 8);
        float mrun[2] = {-1e30f, -1e30f}, lsum[2] = {0.f, 0.f};
        f32x4 ot[2][4];
#pragma unroll
        for (int qb = 0; qb < 2; ++qb)
#pragma unroll
            for (int db = 0; db < 4; ++db) ot[qb][db] = (f32x4){0.f, 0.f, 0.f, 0.f};
        for (int step = 0; step < nst; ++step) {
            const bool isnew = step == 8;
            bf16x8 kf[2][2]; float fk[2][4];
#pragma unroll
            for (int kb = 0; kb < 2; ++kb)
#pragma unroll
                for (int ks = 0; ks < 2; ++ks) { const f32x4 x0 = kr[(kb * 2 + ks) * 2], x1 = kr[(kb * 2 + ks) * 2 + 1];
                    u32x4 w; w.x = cvt_pk_bf16(x0[0], x0[1]); w.y = cvt_pk_bf16(x0[2], x0[3]); w.z = cvt_pk_bf16(x1[0], x1[1]); w.w = cvt_pk_bf16(x1[2], x1[3]); kf[kb][ks] = __builtin_bit_cast(bf16x8, w); }
#pragma unroll
            for (int i = 0; i < 8; ++i) { const int key = i * 4 + g;
#pragma unroll
                for (int c = 0; c < 4; ++c) Vt[(li * 4 + c) * 40 + key] = f2bf(vr[i][c]); }
#pragma unroll
            for (int kb = 0; kb < 2; ++kb)
#pragma unroll
                for (int j = 0; j < 4; ++j) { const int kk = kb * 16 + g * 4 + j; const float cn = __shfl(cst, kk); fk[kb][j] = (isnew ? FcLast + cn : fkr[kb * 4 + j]) * LOG2E; }
            asm volatile("s_waitcnt lgkmcnt(0)" ::: "memory");
            if (step + 1 < nst) ATS_ISSUE(it, step + 1);
            else if (it + nb < 256) ATS_ISSUE(it + nb, 0);
            f32x4 st[2][2];
#pragma unroll
            for (int kb = 0; kb < 2; ++kb)
#pragma unroll
                for (int qb = 0; qb < 2; ++qb) { f32x4 z = (f32x4){0.f, 0.f, 0.f, 0.f};
                    z = __builtin_amdgcn_mfma_f32_16x16x32_bf16(kf[kb][0], qf[qb][0], z, 0, 0, 0);
                    st[qb][kb] = __builtin_amdgcn_mfma_f32_16x16x32_bf16(kf[kb][1], qf[qb][1], z, 0, 0, 0); }
#pragma unroll
            for (int qb = 0; qb < 2; ++qb) {
                const int qq = qb * 16 + li;
                float mx = -1e30f;
#pragma unroll
                for (int kb = 0; kb < 2; ++kb)
#pragma unroll
                    for (int j = 0; j < 4; ++j) { float s = st[qb][kb][j] * (0.125f * LOG2E) + (Fq[qb] - fk[kb][j]); const int kk = kb * 16 + g * 4 + j;
                        if (isnew && kk > qq) s = -1e30f; st[qb][kb][j] = s; mx = fmaxf(mx, s); }
                mx = fmaxf(mx, __shfl_xor(mx, 16)); mx = fmaxf(mx, __shfl_xor(mx, 32));
                const float mn = fmaxf(mrun[qb], mx); const float alpha = __builtin_amdgcn_exp2f(mrun[qb] - mn); mrun[qb] = mn;
                float ps = 0.f;
#pragma unroll
                for (int kb = 0; kb < 2; ++kb)
#pragma unroll
                    for (int j = 0; j < 4; ++j) { const float pv = __builtin_amdgcn_exp2f(st[qb][kb][j] - mn); st[qb][kb][j] = pv; ps += pv; }
                lsum[qb] = lsum[qb] * alpha + ps;
#pragma unroll
                for (int db = 0; db < 4; ++db) ot[qb][db] *= alpha;
            }
            bf16x8 pf[2];
#pragma unroll
            for (int qb = 0; qb < 2; ++qb) { u32x4 w; w.x = cvt_pk_bf16(st[qb][0][0], st[qb][0][1]); w.y = cvt_pk_bf16(st[qb][0][2], st[qb][0][3]);
                w.z = cvt_pk_bf16(st[qb][1][0], st[qb][1][1]); w.w = cvt_pk_bf16(st[qb][1][2], st[qb][1][3]); pf[qb] = __builtin_bit_cast(bf16x8, w); }
#pragma unroll
            for (int db = 0; db < 4; ++db) {
                const u32x2 va = *(const LAS u32x2*)(Vt + (db * 16 + li) * 40 + g * 4), vb2 = *(const LAS u32x2*)(Vt + (db * 16 + li) * 40 + 16 + g * 4);
                const u32x4 vc = {va.x, va.y, vb2.x, vb2.y}; const bf16x8 vf = __builtin_bit_cast(bf16x8, vc);
#pragma unroll
                for (int qb = 0; qb < 2; ++qb) ot[qb][db] = __builtin_amdgcn_mfma_f32_16x16x32_bf16(vf, pf[qb], ot[qb][db], 0, 0, 0);
            }
            asm volatile("s_waitcnt lgkmcnt(0)" ::: "memory");
        }
#pragma unroll
        for (int qb = 0; qb < 2; ++qb) {
            float lt = lsum[qb]; lt += __shfl_xor(lt, 16); lt += __shfl_xor(lt, 32);
            LAS float* rowp = cmb + (wave * 32 + qb * 16 + li) * 66;
#pragma unroll
            for (int db = 0; db < 4; ++db)
#pragma unroll
                for (int j = 0; j < 4; ++j) rowp[db * 16 + g * 4 + j] = ot[qb][db][j];
            if (g == 0) { rowp[64] = mrun[qb]; rowp[65] = lt; }
        }
        __syncthreads();
        {
            const int q = tid >> 4, dq = (tid & 15) * 4;
            float M = -1e30f;
#pragma unroll
            for (int w = 0; w < 8; ++w) M = fmaxf(M, cmb[(w * 32 + q) * 66 + 64]);
            float Lt = 0.f; f32x4 O = (f32x4){0.f, 0.f, 0.f, 0.f};
#pragma unroll
            for (int w = 0; w < 8; ++w) { LAS const float* rp = cmb + (w * 32 + q) * 66; const float e = __builtin_amdgcn_exp2f(rp[64] - M); Lt += rp[65] * e;
                O[0] += rp[dq] * e; O[1] += rp[dq + 1] * e; O[2] += rp[dq + 2] * e; O[3] += rp[dq + 3] * e; }
            *(f32x4*)((float*)(p.ws + W_PO) + ((size_t)it * 32 + q) * 64 + dq) = O;
            if ((tid & 15) == 0) { ((float*)(p.ws + W_PM))[it * 32 + q] = M; ((float*)(p.ws + W_PL))[it * 32 + q] = Lt; }
        }
        __syncthreads();
    }
#undef ATS_ISSUE
}

__device__ __forceinline__ void attn_sample_combine(const Params& p, int bh) {
    const int tid = fresh_tid(), q = tid >> 4, dq = (tid & 15) * 4, b = bh >> 3, h = bh & 7;
    const float* PO = (const float*)(p.ws + W_PO); const float* PM = (const float*)(p.ws + W_PM); const float* PL = (const float*)(p.ws + W_PL);
    float M = -1e30f;
#pragma unroll
    for (int s = 0; s < 2; ++s) M = fmaxf(M, PM[(bh * 2 + s) * 32 + q]);
    float Lt = 0.f; f32x4 O = (f32x4){0.f, 0.f, 0.f, 0.f};
#pragma unroll
    for (int s = 0; s < 2; ++s) { const float e = __builtin_amdgcn_exp2f(PM[(bh * 2 + s) * 32 + q] - M); Lt += PL[(bh * 2 + s) * 32 + q] * e; O += *(const f32x4*)(PO + ((size_t)(bh * 2 + s) * 32 + q) * 64 + dq) * e; }
    const float inv = 1.f / Lt; O *= inv;
    u32x2 w; w.x = cvt_pk_bf16(O[0], O[1]); w.y = cvt_pk_bf16(O[2], O[3]);
    *(u32x2*)((bf16_t*)(p.ws + W_MIX) + (size_t)(TP + b * 32 + q) * DM + 256 + h * 64 + dq) = w;
}

__device__ __forceinline__ void lru_local_item(const Params& p, int l, int ci, LAS unsigned char* lds) {
    const int tid = fresh_tid(), wave = tid >> 6, lane = tid & 63, g = lane >> 4, li = lane & 15; const CItem it = citem(ci); const int L = it.L, row0 = it.row0;
    LAS float* xs = (LAS float*)lds; LAS float* us = xs + 67 * 256;
    const float* proj = (const float*)(p.ws + W_PROJ);
    const int hd = wave >> 1, jh = wave & 1;
    __syncthreads();
    for (int i = tid; i < (L + 3) * 64; i += 512) { const int r = i >> 6, c4 = (i & 63) * 4, t = r - 3; f32x4 v;
        if (t >= 0 || (it.prompt && it.c > 0)) v = *(const f32x4*)(proj + (size_t)(row0 + t) * NIN + c4);
        else if (it.prompt) v = (f32x4){0.f, 0.f, 0.f, 0.f};
        else v = *(const f32x4*)(p.in[I_SLCONV] + ((l * 16 + it.b) * 3 + r) * 256 + c4);
        *(LAS f32x4*)(xs + r * 256 + c4) = v; }
    bf16x8 Wf[2][2][2];
#pragma unroll
    for (int gate = 0; gate < 2; ++gate)
#pragma unroll
        for (int jb = 0; jb < 2; ++jb)
#pragma unroll
            for (int ks = 0; ks < 2; ++ks) { const float* wp = (gate ? p.in[I_LWX] : p.in[I_LWA]) + (size_t)((l * 4 + hd) * 64 + ks * 32 + g * 8) * 64 + jh * 32 + jb * 16 + li;
                float w[8];
#pragma unroll
                for (int e = 0; e < 8; ++e) w[e] = wp[e * 64];
                u32x4 pk; pk.x = cvt_pk_bf16(w[0], w[1]); pk.y = cvt_pk_bf16(w[2], w[3]); pk.z = cvt_pk_bf16(w[4], w[5]); pk.w = cvt_pk_bf16(w[6], w[7]); Wf[gate][jb][ks] = __builtin_bit_cast(bf16x8, pk); }
    __syncthreads();
    {   const int ch = tid & 255, tb0 = (tid >> 8) * 32;
        if (tb0 < L) {
            const float w0 = p.in[I_LCW][(l * 4 + 0) * 256 + ch], w1 = p.in[I_LCW][(l * 4 + 1) * 256 + ch], w2 = p.in[I_LCW][(l * 4 + 2) * 256 + ch], w3 = p.in[I_LCW][(l * 4 + 3) * 256 + ch], bb = p.in[I_LCB][l * 256 + ch];
            for (int t = tb0; t < tb0 + 32; ++t) us[t * 260 + ch] = bb + w0 * xs[t * 256 + ch] + w1 * xs[(t + 1) * 256 + ch] + w2 * xs[(t + 2) * 256 + ch] + w3 * xs[(t + 3) * 256 + ch];
        } }
    __syncthreads();
    float bav[2], bxv[2], spl[2]; float Pc[2] = {1.f, 1.f}, Hc[2] = {0.f, 0.f};
#pragma unroll
    for (int jb = 0; jb < 2; ++jb) { const int ch = hd * 64 + jh * 32 + jb * 16 + li; bav[jb] = p.in[I_LBA][l * 256 + ch]; bxv[jb] = p.in[I_LBX][l * 256 + ch]; spl[jb] = softplus_f(-p.in[I_LLAM][l * 256 + ch]); }
    float* acum = (float*)(p.ws + W_ACUM); float* hloc = (float*)(p.ws + W_HLOC);
    for (int tb = 0; tb * 16 < L; ++tb) {
        bf16x8 Uf[2];
#pragma unroll
        for (int ks = 0; ks < 2; ++ks) { LAS const float* up = us + (tb * 16 + li) * 260 + hd * 64 + ks * 32 + g * 8; const f32x4 x0 = *(const LAS f32x4*)up, x1 = *(const LAS f32x4*)(up + 4);
            u32x4 pk; pk.x = cvt_pk_bf16(x0[0], x0[1]); pk.y = cvt_pk_bf16(x0[2], x0[3]); pk.z = cvt_pk_bf16(x1[0], x1[1]); pk.w = cvt_pk_bf16(x1[2], x1[3]); Uf[ks] = __builtin_bit_cast(bf16x8, pk); }
#pragma unroll
        for (int jb = 0; jb < 2; ++jb) {
            f32x4 ga = (f32x4){0.f, 0.f, 0.f, 0.f}, gx = (f32x4){0.f, 0.f, 0.f, 0.f};
#pragma unroll
            for (int ks = 0; ks < 2; ++ks) { ga = __builtin_amdgcn_mfma_f32_16x16x32_bf16(Uf[ks], Wf[0][jb][ks], ga, 0, 0, 0); gx = __builtin_amdgcn_mfma_f32_16x16x32_bf16(Uf[ks], Wf[1][jb][ks], gx, 0, 0, 0); }
            const int ch = hd * 64 + jh * 32 + jb * 16 + li;
            float Pl[4], Hl[4];
#pragma unroll
            for (int jj = 0; jj < 4; ++jj) { const int t = tb * 16 + g * 4 + jj;
                const float r = sigmoid_f(ga[jj] + bav[jb]), ig = sigmoid_f(gx[jj] + bxv[jb]); const float la = -8.f * r * spl[jb]; const float a = __expf(la);
                const float bc = sqrtf(fmaxf(1.f - a * a, 0.f)) * (ig * us[t * 260 + ch]);
                if (jj == 0) { Pl[0] = a; Hl[0] = bc; } else { Pl[jj] = Pl[jj - 1] * a; Hl[jj] = a * Hl[jj - 1] + bc; } }
            float EP = 1.f, EH = 0.f;
#pragma unroll
            for (int gg = 0; gg < 3; ++gg) { const float Pg = __shfl(Pl[3], li + 16 * gg), Hg = __shfl(Hl[3], li + 16 * gg); if (gg < g) { EH = Pg * EH + Hg; EP *= Pg; } }
            const float Pin = Pc[jb] * EP, Hin = EP * Hc[jb] + EH;
#pragma unroll
            for (int jj = 0; jj < 4; ++jj) { const size_t o = (size_t)(row0 + tb * 16 + g * 4 + jj) * 256 + ch; acum[o] = Pin * Pl[jj]; hloc[o] = Pl[jj] * Hin + Hl[jj]; }
            const float Pe = Pin * Pl[3], He = Pl[3] * Hin + Hl[3];
            Pc[jb] = __shfl(Pe, li + 48); Hc[jb] = __shfl(He, li + 48);
        }
    }
    if (g == 0) {
#pragma unroll
        for (int jb = 0; jb < 2; ++jb) { const int ch = hd * 64 + jh * 32 + jb * 16 + li; ((float*)(p.ws + W_AGGA))[ci * 256 + ch] = Pc[jb]; ((float*)(p.ws + W_AGGB))[ci * 256 + ch] = Hc[jb]; } }
    __syncthreads();
}

__device__ __forceinline__ void lru_final_item(const Params& p, int l, int ci) {
    const int tid = fresh_tid(); const CItem it = citem(ci); const int L = it.L, row0 = it.row0;
    const int ch = tid & 255, th = tid >> 8, tb = th * 32;
    const float* proj = (const float*)(p.ws + W_PROJ); const float* aggA = (const float*)(p.ws + W_AGGA); const float* aggB = (const float*)(p.ws + W_AGGB);
    const float* acum = (const float*)(p.ws + W_ACUM); const float* hloc = (const float*)(p.ws + W_HLOC); bf16_t* mixed = (bf16_t*)(p.ws + W_MIX);
    float hin = it.prompt ? 0.f : p.in[I_SLH][(l * 16 + it.b) * 256 + ch];
    for (int c2 = 0; c2 < it.c; c2 += 8) { float aa[8], ab[8];
#pragma unroll
        for (int k = 0; k < 8; ++k) { const int cc = min(c2 + k, it.c - 1); aa[k] = aggA[(ci - it.c + cc) * 256 + ch]; ab[k] = aggB[(ci - it.c + cc) * 256 + ch]; }
#pragma unroll
        for (int k = 0; k < 8; ++k) if (c2 + k < it.c) hin = aa[k] * hin + ab[k]; }
    if (tb < L) {
        for (int t0 = 0; t0 < 32; t0 += 16) {
            float av[16], hl[16], gv[16];
#pragma unroll
            for (int k = 0; k < 16; ++k) { const size_t row = (size_t)(row0 + tb + t0 + k); av[k] = acum[row * 256 + ch]; hl[k] = hloc[row * 256 + ch]; gv[k] = proj[row * NIN + 256 + ch]; }
#pragma unroll
            for (int k = 0; k < 16; ++k) { const size_t row = (size_t)(row0 + tb + t0 + k); const float hv = av[k] * hin + hl[k];
                mixed[row * DM + ch] = f2bf(hv * gelu_tanh_f(gv[k]));
                if (it.lastc && tb + t0 + k == L - 1) p.out[(it.prompt ? O_PLH + (size_t)(l * 8 + it.b) * 256 : O_SLH + (size_t)(l * 16 + it.b) * 256) + ch] = hv; }
        }
    }
    if (it.lastc) for (int i = tid; i < 3 * 256; i += 512) { const int r = i >> 8, c2 = i & 255;
        p.out[(it.prompt ? O_PLCONV + (size_t)((l * 8 + it.b) * 3 + r) * 256 : O_SLCONV + (size_t)((l * 16 + it.b) * 3 + r) * 256) + c2] = proj[(size_t)(row0 + L - 3 + r) * NIN + c2]; }
}

__device__ __forceinline__ void ssd1_item(const Params& p, int l, int ci, LAS unsigned char* lds) {
    const int tid = fresh_tid(), wave = tid >> 6, lane = tid & 63, g = lane >> 4, li = lane & 15; const CItem it = citem(ci); const int L = it.L, row0 = it.row0;
    LAS bf16_t* xdT = (LAS bf16_t*)lds; LAS bf16_t* BT = xdT + 256 * 72;
    LAS float* dts = (LAS float*)(lds + 2 * 256 * 72 * 2); LAS float* cums = dts + 256;
    const float* proj = (const float*)(p.ws + W_PROJ); float* xact = (float*)(p.ws + W_XACT);
    __syncthreads();
    if (tid < L * 4) { const int t = tid >> 2, hh = tid & 3; const float dtv = softplus_f(proj[(size_t)(row0 + t) * NIN + 3080 + hh] + p.in[I_SDTB][l * 4 + hh]);
        dts[tid] = dtv; ((float*)(p.ws + W_DTB))[(size_t)row0 * 4 + tid] = dtv; }
    for (int i = tid; i < L * 8; i += 512) { const int t = i >> 3, hh = i & 7; const float v = logsigmoid_f(proj[(size_t)(row0 + t) * NIN + 3072 + hh] + p.in[I_FBIAS][l * 8 + hh]);
        const int row = row0 + t; p.out[(row < TP ? O_PLOGF + ((size_t)l * TP + row) * 8 : O_SLOGF + ((size_t)l * TS + (row - TP)) * 8) + hh] = v; }
    if (it.lastc) for (int i = tid; i < 3 * 768; i += 512) { const int r = i / 768, c2 = i % 768;
        p.out[(it.prompt ? O_PSCONV + (size_t)((l * 8 + it.b) * 3 + r) * 768 : O_SSCONV + (size_t)((l * 16 + it.b) * 3 + r) * 768) + c2] = proj[(size_t)(row0 + L - 3 + r) * NIN + 2304 + c2]; }
    __syncthreads();
    if (tid < 256) { const int hh = tid >> 6, t = tid & 63; const float A = -expf(p.in[I_SALOG][l * 4 + hh]);
        float v = t < L ? dts[t * 4 + hh] * A : 0.f;
#pragma unroll
        for (int o = 1; o < 64; o <<= 1) { const float n = __shfl_up(v, o); if (t >= o) v += n; }
        if (t < L) { cums[t * 4 + hh] = v; ((float*)(p.ws + W_CUMB))[(size_t)(row0 + t) * 4 + hh] = v; }
        if (t == L - 1) ((float*)(p.ws + W_CDEC))[ci * 4 + hh] = expf(v); }
    __syncthreads();
    for (int task = tid; task < (L >> 3) * 192; task += 512) {
        const int tg = task / 192, ch = (task % 192) * 4, t0 = tg * 8;
        const f32x4 w0 = *(const f32x4*)(p.in[I_SCW] + (l * 4 + 0) * 768 + ch), w1 = *(const f32x4*)(p.in[I_SCW] + (l * 4 + 1) * 768 + ch), w2 = *(const f32x4*)(p.in[I_SCW] + (l * 4 + 2) * 768 + ch),
                    w3 = *(const f32x4*)(p.in[I_SCW] + (l * 4 + 3) * 768 + ch), bb = *(const f32x4*)(p.in[I_SCB] + l * 768 + ch);
        f32x4 xr[11];
#pragma unroll
        for (int r = 0; r < 11; ++r) { const int t = t0 - 3 + r;
            if (t >= 0 || (it.prompt && it.c > 0)) xr[r] = *(const f32x4*)(proj + (size_t)(row0 + t) * NIN + 2304 + ch);
            else if (it.prompt) xr[r] = (f32x4){0.f, 0.f, 0.f, 0.f};
            else xr[r] = *(const f32x4*)(p.in[I_SSCONV] + (size_t)((l * 16 + it.b) * 3 + (t + 3)) * 768 + ch); }
        f32x4 vv[8];
#pragma unroll
        for (int i = 0; i < 8; ++i) { f32x4 v = bb + w0 * xr[i] + w1 * xr[i + 1] + w2 * xr[i + 2] + w3 * xr[i + 3];
            v[0] = silu_f(v[0]); v[1] = silu_f(v[1]); v[2] = silu_f(v[2]); v[3] = silu_f(v[3]);
            *(f32x4*)(xact + (size_t)(row0 + t0 + i) * 768 + ch) = v; vv[i] = v;
            if (ch >= 256) { u32x2 w; w.x = cvt_pk_bf16(v[0], v[1]); w.y = cvt_pk_bf16(v[2], v[3]); *(u32x2*)((bf16_t*)(p.ws + W_XB16) + (size_t)(row0 + t0 + i) * 512 + ch - 256) = w; } }
        if (ch < 512) {
            if (ch < 256) { const int hh = ch >> 6; const float cl = cums[(L - 1) * 4 + hh];
#pragma unroll
                for (int i = 0; i < 8; ++i) vv[i] *= __expf(cl - cums[(t0 + i) * 4 + hh]) * dts[(t0 + i) * 4 + hh]; }
            LAS bf16_t* dst = (ch < 256 ? xdT + ch * 72 : BT + (ch - 256) * 72) + t0;
#pragma unroll
            for (int c = 0; c < 4; ++c) { u32x4 w; w.x = cvt_pk_bf16(vv[0][c], vv[1][c]); w.y = cvt_pk_bf16(vv[2][c], vv[3][c]); w.z = cvt_pk_bf16(vv[4][c], vv[5][c]); w.w = cvt_pk_bf16(vv[6][c], vv[7][c]);
                *(LAS u32x4*)(dst + c * 72) = w; }
        }
    }
    __syncthreads();
    {   const int hh = wave >> 1, ph = wave & 1, gi = hh >> 1; float* states = (float*)(p.ws + W_STATES);
#pragma unroll
        for (int pb = 0; pb < 2; ++pb) {
            bf16x8 Af[2];
#pragma unroll
            for (int ks = 0; ks < 2; ++ks) if (ks * 32 < L) Af[ks] = *(const LAS bf16x8*)(xdT + (hh * 64 + ph * 32 + pb * 16 + li) * 72 + ks * 32 + g * 8);
#pragma unroll
            for (int n8 = 0; n8 < 8; ++n8) {
                f32x4 a = (f32x4){0.f, 0.f, 0.f, 0.f};
#pragma unroll
                for (int ks = 0; ks < 2; ++ks) if (ks * 32 < L) { const bf16x8 Bf = *(const LAS bf16x8*)(BT + (gi * 128 + n8 * 16 + li) * 72 + ks * 32 + g * 8); a = __builtin_amdgcn_mfma_f32_16x16x32_bf16(Af[ks], Bf, a, 0, 0, 0); }
#pragma unroll
                for (int jj = 0; jj < 4; ++jj) states[((size_t)(ci * 4 + hh) * 64 + ph * 32 + pb * 16 + g * 4 + jj) * 128 + n8 * 16 + li] = a[jj];
            }
        }
    }
    __syncthreads();
}

__device__ __forceinline__ void ssd_scan_item(const Params& p, int l, int idx) {
    const int tid = fresh_tid(); float* states = (float*)(p.ws + W_STATES); const float* cdec = (const float*)(p.ws + W_CDEC);
    if (idx < 128) { const int seq = idx >> 4, e0 = (idx & 15) * 2048 + tid * 4, hh = e0 >> 13;
        f32x4 run = (f32x4){0.f, 0.f, 0.f, 0.f};
        for (int c0 = 0; c0 < 32; c0 += 8) { f32x4 st[8]; float dec[8];
#pragma unroll
            for (int k = 0; k < 8; ++k) { const int ci = seq * 32 + c0 + k; dec[k] = cdec[ci * 4 + hh]; st[k] = *(const f32x4*)(states + (size_t)ci * 32768 + e0); }
#pragma unroll
            for (int k = 0; k < 8; ++k) { const int ci = seq * 32 + c0 + k; *(f32x4*)(states + (size_t)ci * 32768 + e0) = run;
                u32x2 w; w.x = cvt_pk_bf16(run[0], run[1]); w.y = cvt_pk_bf16(run[2], run[3]); *(u32x2*)((bf16_t*)(p.ws + W_HS16) + (size_t)ci * 32768 + e0) = w; run = dec[k] * run + st[k]; } }
        *(f32x4*)(p.out + O_PSH + (size_t)(l * 8 + seq) * 32768 + e0) = run;
    } else { const int b = (idx - 128) >> 4, e0 = ((idx - 128) & 15) * 2048 + tid * 4, hh = e0 >> 13, ci = 256 + b;
        const f32x4 h0 = *(const f32x4*)(p.in[I_SSH] + (size_t)(l * 16 + b) * 32768 + e0); const float dec = cdec[ci * 4 + hh]; float* sp = states + (size_t)ci * 32768 + e0; const f32x4 st = *(const f32x4*)sp;
        *(f32x4*)(p.out + O_SSH + (size_t)(l * 16 + b) * 32768 + e0) = dec * h0 + st; }
}

__device__ __forceinline__ bf16x8 frag_from_f32(const float* a) {
    const f32x4 x0 = *(const f32x4*)a, x1 = *(const f32x4*)(a + 4);
    u32x4 w; w.x = cvt_pk_bf16(x0[0], x0[1]); w.y = cvt_pk_bf16(x0[2], x0[3]); w.z = cvt_pk_bf16(x1[0], x1[1]); w.w = cvt_pk_bf16(x1[2], x1[3]);
    return __builtin_bit_cast(bf16x8, w);
}
__device__ __forceinline__ void ssd3_item(const Params& p, int l, int ci, LAS unsigned char* lds) {
    const int tid = fresh_tid(), wave = tid >> 6, lane = tid & 63, g = lane >> 4, li = lane & 15; const CItem it = citem(ci); const int L = it.L, row0 = it.row0;
    const int hh = wave >> 1, qh = wave & 1, gi = hh >> 1;
    LAS bf16_t* xT = (LAS bf16_t*)lds + wave * (64 * 72);
    LAS float* cumT = (LAS float*)(lds + 8 * 64 * 72 * 2); LAS float* dtT = cumT + 256; LAS float* ssqp = dtT + 256;
    const float* xact = (const float*)(p.ws + W_XACT); const float* proj = (const float*)(p.ws + W_PROJ);
    const bf16_t* xb16 = (const bf16_t*)(p.ws + W_XB16); const bf16_t* hs16 = (const bf16_t*)(p.ws + W_HS16) + (size_t)(it.prompt ? ci : 0) * 32768;
    const float* hst = it.prompt ? (const float*)(p.ws + W_STATES) + (size_t)ci * 32768 : p.in[I_SSH] + (size_t)(l * 16 + it.b) * 32768;
    const bool qact = qh * 32 < L;
    __syncthreads();
    if (tid < L * 4) { const int t = tid >> 2, h2 = tid & 3; cumT[h2 * 64 + t] = ((const float*)(p.ws + W_CUMB))[(size_t)row0 * 4 + tid]; dtT[h2 * 64 + t] = ((const float*)(p.ws + W_DTB))[(size_t)row0 * 4 + tid]; }
    {
        for (int i = 0; i < (L >> 2); ++i) { const int s = i * 4 + g; const f32x4 v = *(const f32x4*)(xact + (size_t)(row0 + s) * 768 + hh * 64 + li * 4);
#pragma unroll
            for (int c = 0; c < 4; ++c) xT[(li * 4 + c) * 72 + s] = f2bf(v[c]); }
    }
    f32x4 yt[2][4];
#pragma unroll
    for (int qb = 0; qb < 2; ++qb)
#pragma unroll
        for (int pb = 0; pb < 4; ++pb) yt[qb][pb] = (f32x4){0.f, 0.f, 0.f, 0.f};
    bf16x8 Cf[2][4];
    f32x4 cb[2][4];
    if (qact) {
#pragma unroll
        for (int qb = 0; qb < 2; ++qb)
#pragma unroll
            for (int ks = 0; ks < 4; ++ks) Cf[qb][ks] = *(const bf16x8*)(xb16 + (size_t)(row0 + qh * 32 + qb * 16 + li) * 512 + 256 + gi * 128 + ks * 32 + g * 8);
        {   bf16x8 Bf[4][4];
#pragma unroll
            for (int sb = 0; sb < 4; ++sb)
#pragma unroll
                for (int ks = 0; ks < 4; ++ks) if (sb * 16 < L) Bf[sb][ks] = *(const bf16x8*)(xb16 + (size_t)(row0 + sb * 16 + li) * 512 + gi * 128 + ks * 32 + g * 8);
#pragma unroll
            for (int sb = 0; sb < 4; ++sb) {
                if (sb * 16 < L) {
#pragma unroll
                    for (int qb = 0; qb < 2; ++qb) { f32x4 a = (f32x4){0.f, 0.f, 0.f, 0.f};
#pragma unroll
                        for (int ks = 0; ks < 4; ++ks) a = __builtin_amdgcn_mfma_f32_16x16x32_bf16(Bf[sb][ks], Cf[qb][ks], a, 0, 0, 0);
                        cb[qb][sb] = a; }
                } else { cb[0][sb] = (f32x4){0.f, 0.f, 0.f, 0.f}; cb[1][sb] = (f32x4){0.f, 0.f, 0.f, 0.f}; }
            }
        }
        {
            bf16x8 Hf[4][4];
#pragma unroll
            for (int pb = 0; pb < 4; ++pb)
#pragma unroll
                for (int ks = 0; ks < 4; ++ks) { const size_t ho = ((size_t)hh * 64 + pb * 16 + li) * 128 + ks * 32 + g * 8; Hf[pb][ks] = it.prompt ? *(const bf16x8*)(hs16 + ho) : frag_from_f32(hst + ho); }
#pragma unroll
            for (int pb = 0; pb < 4; ++pb)
#pragma unroll
                for (int qb = 0; qb < 2; ++qb)
#pragma unroll
                    for (int ks = 0; ks < 4; ++ks) yt[qb][pb] = __builtin_amdgcn_mfma_f32_16x16x32_bf16(Hf[pb][ks], Cf[qb][ks], yt[qb][pb], 0, 0, 0);
        }
    }
    __syncthreads();
    float ssq[2] = {0.f, 0.f};
    f32x4 vv[2][4];
    if (qact) {
        bf16x8 Wf[2][2];
#pragma unroll
        for (int qb = 0; qb < 2; ++qb) {
            const int q = qh * 32 + qb * 16 + li; const float cq = cumT[hh * 64 + q]; const float eq = __expf(cq);
#pragma unroll
            for (int pb = 0; pb < 4; ++pb) yt[qb][pb] *= eq;
            float wv[4][4];
#pragma unroll
            for (int sb = 0; sb < 4; ++sb) {
                if (sb * 16 < L) {
                    const f32x4 cs = *(const LAS f32x4*)(cumT + hh * 64 + sb * 16 + g * 4), ds = *(const LAS f32x4*)(dtT + hh * 64 + sb * 16 + g * 4);
#pragma unroll
                    for (int j = 0; j < 4; ++j) { const int s = sb * 16 + g * 4 + j; wv[sb][j] = s <= q ? cb[qb][sb][j] * __expf(cq - cs[j]) * ds[j] : 0.f; }
                } else {
#pragma unroll
                    for (int j = 0; j < 4; ++j) wv[sb][j] = 0.f; }
            }
#pragma unroll
            for (int kst = 0; kst < 2; ++kst) { u32x4 w; w.x = cvt_pk_bf16(wv[2 * kst][0], wv[2 * kst][1]); w.y = cvt_pk_bf16(wv[2 * kst][2], wv[2 * kst][3]);
                w.z = cvt_pk_bf16(wv[2 * kst + 1][0], wv[2 * kst + 1][1]); w.w = cvt_pk_bf16(wv[2 * kst + 1][2], wv[2 * kst + 1][3]); Wf[qb][kst] = __builtin_bit_cast(bf16x8, w); }
        }
#pragma unroll
        for (int kst = 0; kst < 2; ++kst) {
            if (kst * 32 < L) {
#pragma unroll
                for (int pb = 0; pb < 4; ++pb) {
                    const u32x2 va = *(const LAS u32x2*)(xT + (pb * 16 + li) * 72 + kst * 32 + g * 4), vb2 = *(const LAS u32x2*)(xT + (pb * 16 + li) * 72 + kst * 32 + 16 + g * 4);
                    const u32x4 vc = {va.x, va.y, vb2.x, vb2.y}; const bf16x8 xf = __builtin_bit_cast(bf16x8, vc);
#pragma unroll
                    for (int qb = 0; qb < 2; ++qb) yt[qb][pb] = __builtin_amdgcn_mfma_f32_16x16x32_bf16(xf, Wf[qb][kst], yt[qb][pb], 0, 0, 0);
                }
            }
        }
        const float Dh = p.in[I_SD][l * 4 + hh];
#pragma unroll
        for (int qb = 0; qb < 2; ++qb) { const size_t row = (size_t)(row0 + qh * 32 + qb * 16 + li);
#pragma unroll
            for (int pb = 0; pb < 4; ++pb) { const int pc = hh * 64 + pb * 16 + g * 4;
                const f32x4 xq = *(const f32x4*)(xact + row * 768 + pc), z = *(const f32x4*)(proj + row * NIN + 2048 + pc);
                f32x4 v = yt[qb][pb] + Dh * xq;
#pragma unroll
                for (int j = 0; j < 4; ++j) { v[j] *= silu_f(z[j]); ssq[qb] += v[j] * v[j]; }
                vv[qb][pb] = v; }
            ssq[qb] += __shfl_xor(ssq[qb], 16); ssq[qb] += __shfl_xor(ssq[qb], 32);
            if (g == 0) ssqp[hh * 64 + qh * 32 + qb * 16 + li] = ssq[qb]; }
    }
    __syncthreads();
    if (qact) {
#pragma unroll
        for (int qb = 0; qb < 2; ++qb) { const int q = qh * 32 + qb * 16 + li; const float tot = ssqp[q] + ssqp[64 + q] + ssqp[128 + q] + ssqp[192 + q];
            const float r = rsqrtf(tot * (1.f / 256.f) + EPS); const size_t row = (size_t)(row0 + q);
#pragma unroll
            for (int pb = 0; pb < 4; ++pb) { const int pc = hh * 64 + pb * 16 + g * 4; const f32x4 w = *(const f32x4*)(p.in[I_SNW] + l * 256 + pc); const f32x4 o = (vv[qb][pb] * r) * w;
                u32x2 pk; pk.x = cvt_pk_bf16(o[0], o[1]); pk.y = cvt_pk_bf16(o[2], o[3]);
                *(u32x2*)((bf16_t*)(p.ws + W_MIX) + row * DM + 768 + pc) = pk; } }
    }
    __syncthreads();
}

constexpr int NPH = 2 + 2 * 12;
__global__ void __launch_bounds__(512, 2) mega(Params p) {
    extern __shared__ __attribute__((aligned(16))) unsigned char smem[];
    LAS unsigned char* lds = (LAS unsigned char*)smem;
    cg::grid_group grid = cg::this_grid();
    const int bid = blockIdx.x, nb = gridDim.x;
    int ph = 0;
    unsigned* barw = (unsigned*)(p.ws + W_BAR);
    volatile LAS unsigned* bst = (volatile LAS unsigned*)(lds + LDS_MAIN);
    XcdBarrier xb; xb.bar = barw; xb.x = 0; xb.st = bst;
#if COOP
    if (threadIdx.x < 4) bst[threadIdx.x] = 0u;
    if (bid == 0) for (int i = threadIdx.x; i < XCD_BAR_WORDS; i += 512) barw[i] = 0u;
#endif
#define PH_BEGIN if (ph >= p.ph_lo && ph < p.ph_hi) {
#define PH_END if (ph + 1 < p.ph_hi) for (int rs = 0; rs < REP_SYNC; ++rs) xcd_barrier(xb); } ++ph;
    PH_BEGIN for (int rep = 0; rep < REP_PREP; ++rep) prep_phase(p, lds, bid, nb);
        if (ph + 1 < p.ph_hi) { grid.sync(); xb = xcd_barrier_post(barw, bst); } } ++ph;
    PH_BEGIN for (int rep = 0; rep < REP_N0; ++rep) norm_phase(p, true, false, 0, 0, 0.f, 0, 0, 0, 1, bid, nb); PH_END
    for (int l = 0; l < 2; ++l) {
        const bf16_t* H = (const bf16_t*)(p.ws + W_H); const bf16_t* ACT = (const bf16_t*)(p.ws + W_ACT); const bf16_t* MIX = (const bf16_t*)(p.ws + W_MIX);
        for (int f = 0; f < 2; ++f) {
            if (f == 1) {
                PH_BEGIN {
                    pg8::Gemm g{H, (const bf16_t*)(p.ws + W_IN) + (size_t)l * NIN * DM, DM, DM}; pg8::StaticOrder S; S.init(TT, NIN, DM, nb, bid);
                    pg8::EpiIn E{(float*)(p.ws + W_PROJ), (bf16_t*)(p.ws + W_QB), (bf16_t*)(p.ws + W_KB), (bf16_t*)(p.ws + W_VB),
                                 p.out + O_PK + (size_t)l * TP * 512, p.out + O_SK + (size_t)l * TS * 512, p.out + O_PV + (size_t)l * TP * 512, p.out + O_SV + (size_t)l * TS * 512};
                    for (int rep = 0; rep < REP_IN; ++rep) pg8::gemm_phase(lds, g, S, E);
                    {
                        const int first = (66 * 13) % nb; if (bid >= first) { const int rel = bid - first, st = nb - first;
                            wconv(p, lds, WT_OUT + l * 64, 64, (l * 2 + 1) * 352, 352, WT_D + (l * 2 + 1) * 176, 176, rel, st); } } } PH_END
                PH_BEGIN {
                    for (int s = 0; s < 2; ++s) {
                        if (((s ^ (bid >> 3)) & 1) == 0) { for (int rep = 0; rep < REP_ATTP; ++rep) for (int it = bid; it < 256; it += nb) attn_prompt_item(p, l, it, lds); }
                        else { for (int rep = 0; rep < REP_ATTS; ++rep) attn_sample_block(p, l, bid, nb, lds); } }
                    for (int rep = 0; rep < REP_LRU1; ++rep) { for (int it = bid; it < 256; it += nb) lru_local_item(p, l, it, lds); for (int k = 0; k < 16; ++k) if ((32 + k) % nb == bid) lru_local_item(p, l, 256 + k, lds); }
                    for (int rep = 0; rep < REP_SSD1; ++rep) { for (int it = bid; it < 256; it += nb) ssd1_item(p, l, it, lds); for (int k = 0; k < 16; ++k) if ((16 + k) % nb == bid) ssd1_item(p, l, 256 + k, lds); } } PH_END
                for (int sub = 0; sub < 2; ++sub) {
                    PH_BEGIN {
                        if (sub == 0) {
                            for (int it = bid; it < 384; it += nb) ssd_scan_item(p, l, it);
                            for (int rep = 0; rep < REP_LRUF; ++rep) for (int it = bid; it < NCI; it += nb) lru_final_item(p, l, it);
                            for (int rep = 0; rep < REP_COMB; ++rep) for (int it = bid; it < 128; it += nb) attn_sample_combine(p, it);
                        }
                        const int first = sub == 0 ? 256 + (nb - 1 - bid) : bid, limit = sub == 0 ? NCI : 256;
                        for (int rep = 0; rep < REP_M3; ++rep) for (int it = first; it < limit; it += nb) ssd3_item(p, l, it, lds);
                    } PH_END
                }
                PH_BEGIN {
                    pg8::Gemm g{MIX, (const bf16_t*)(p.ws + W_OUT) + (size_t)l * DM * DM, DM, DM}; pg8::SampleSplitOrder S; S.init(DM, DM, nb, bid);
                    pg8::EpiY E{(bf16_t*)(p.ws + W_Y), (float*)(p.ws + W_YS)}; for (int rep = 0; rep < REP_OUT; ++rep) pg8::gemm_phase(lds, g, S, E); } PH_END
                PH_BEGIN for (int rep = 0; rep < REP_NORM; ++rep) norm_phase(p, false, false, l, 1, 1.0f, l, 2, 4, (l * 3 + 1) & 1, bid, nb); PH_END
            }
            PH_BEGIN {
                pg8::Gemm g{H, (const bf16_t*)(p.ws + W_GU) + (size_t)(l * 2 + f) * NGU * DM, DM, DM}; pg8::StaticOrder S; S.init(TT, NGU, DM, nb, bid);
                pg8::EpiGU E{(bf16_t*)(p.ws + W_ACT)}; for (int rep = 0; rep < REP_GU; ++rep) pg8::gemm_phase(lds, g, S, E);
                {
                    const int first = (66 * 22) % nb; if (bid >= first) { const int rel = bid - first, st = nb - first;
                        const int lo0 = f == 0 ? WT_D + (l * 2) * 176 : 2 * 352, n0 = f == 0 ? 176 : (l == 0 ? 352 : 0), lo1 = WT_IN + l * 208, n1 = f == 0 ? 208 : 0;
                        wconv(p, lds, lo0, n0, lo1, n1, 0, 0, rel, st); } } } PH_END
            PH_BEGIN {
                pg8::Gemm g{ACT, (const bf16_t*)(p.ws + W_D) + (size_t)(l * 2 + f) * DM * DFF, DFF, DFF}; pg8::SampleSplitOrder S; S.init(DM, DFF, nb, bid);
                pg8::EpiY E{(bf16_t*)(p.ws + W_Y), (float*)(p.ws + W_YS)}; for (int rep = 0; rep < REP_DN; ++rep) pg8::gemm_phase(lds, g, S, E); } PH_END
            if (f == 0) { PH_BEGIN for (int rep = 0; rep < REP_NORM; ++rep) norm_phase(p, false, false, l, 0, 0.5f, l, 1, 11, (l * 3) & 1, bid, nb); PH_END }
            else { PH_BEGIN for (int rep = 0; rep < REP_NORM; ++rep) norm_phase(p, false, l == 1, l, 2, 0.5f, l + 1, 0, 11, (l * 3 + 2) & 1, bid, nb); PH_END }
        }
    }
#undef PH_BEGIN
#undef PH_END
}

extern "C" void kernel_launch(void* const* d_in, const int* in_sizes, int n_in, void* d_out, int out_size, void* d_ws, size_t ws_size, hipStream_t stream) {
    static int grid = 0;
    if (grid == 0) {
        if (n_in != 34 || ws_size < W_END) { fprintf(stderr, "kernel_launch: unexpected n_in %d or ws %zu < %zu\n", n_in, ws_size, (size_t)W_END); grid = -1; return; }
        int dev = 0, cus = 0, per_cu = 0;
        (void)hipGetDevice(&dev); (void)hipDeviceGetAttribute(&cus, hipDeviceAttributeMultiprocessorCount, dev);
        if (hipFuncSetAttribute((const void*)mega, hipFuncAttributeMaxDynamicSharedMemorySize, LDS_BYTES) != hipSuccess) { fprintf(stderr, "kernel_launch: hipFuncSetAttribute failed\n"); grid = -1; return; }
        if (hipOccupancyMaxActiveBlocksPerMultiprocessor(&per_cu, (const void*)mega, 512, LDS_BYTES) != hipSuccess || per_cu < 1) { fprintf(stderr, "kernel_launch: occupancy query says %d\n", per_cu); per_cu = 1; }
        (void)hipGetLastError();
        grid = cus;
    }
    if (grid < 0) return;
    Params p{};
    for (int i = 0; i < 34; ++i) p.in[i] = (const float*)d_in[i];
    p.out = (float*)d_out; p.ws = (unsigned char*)d_ws;
#if COOP
    p.ph_lo = 0; p.ph_hi = NPH;
    void* args[] = {&p};
    hipError_t e = hipLaunchCooperativeKernel((const void*)mega, dim3(grid), dim3(512), args, LDS_BYTES, stream);
    if (e != hipSuccess) fprintf(stderr, "cooperative launch failed: %s (grid %d)\n", hipGetErrorString(e), grid);
#else
    for (int ph = 0; ph < NPH; ++ph) { p.ph_lo = ph; p.ph_hi = ph + 1; hipLaunchKernelGGL(mega, dim3(grid), dim3(512), LDS_BYTES, stream, p); }
#endif
}
```

```cpp
#include <hip/hip_runtime.h>
#include <hip/hip_cooperative_groups.h>
#include <cstdio>
namespace cg = cooperative_groups;

#ifndef COOP
#define COOP 1
#endif

#ifndef REP_GEMM
#define REP_GEMM 1
#endif
#ifndef REP_IN
#define REP_IN REP_GEMM
#endif
#ifndef REP_OUT
#define REP_OUT REP_GEMM
#endif
#ifndef REP_GU
#define REP_GU REP_GEMM
#endif
#ifndef REP_DN
#define REP_DN REP_GEMM
#endif
#ifndef REP_LRUF
#define REP_LRUF 1
#endif
#ifndef REP_COMB
#define REP_COMB 1
#endif
#ifndef REP_NORM
#define REP_NORM 1
#endif
#ifndef REP_PREP
#define REP_PREP 1
#endif
#ifndef REP_N0
#define REP_N0 1
#endif
#ifndef REP_ATTP
#define REP_ATTP 1
#endif
#ifndef REP_ATTS
#define REP_ATTS 1
#endif
#ifndef REP_LRU1
#define REP_LRU1 1
#endif
#ifndef REP_SSD1
#define REP_SSD1 1
#endif
#ifndef REP_M3
#define REP_M3 1
#endif
#ifndef REP_SYNC
#define REP_SYNC 1
#endif
#define LAS __attribute__((address_space(3)))
typedef unsigned short bf16_t;
typedef short bf16x8 __attribute__((ext_vector_type(8)));
typedef float f32x4 __attribute__((ext_vector_type(4)));
typedef unsigned u32x4 __attribute__((ext_vector_type(4)));
typedef unsigned u32x2 __attribute__((ext_vector_type(2)));

constexpr int DM = 1024, TP = 16384, TS = 512, TT = TP + TS, NSEQ = 24;
constexpr int DFF = 2816, NGU = 2 * DFF, NIN = 3328, DIN = 3084;
constexpr int NCI = 272;
constexpr float EPS = 1e-6f;
constexpr int LDS_MAIN = 147456, LDS_BYTES = LDS_MAIN + 16;

constexpr size_t O_Y = 0;
constexpr size_t O_PK = (size_t)TT * DM;
constexpr size_t O_PV = O_PK + (size_t)2 * TP * 512;
constexpr size_t O_PLOGF = O_PV + (size_t)2 * TP * 512;
constexpr size_t O_PLCONV = O_PLOGF + (size_t)2 * TP * 8;
constexpr size_t O_PLH = O_PLCONV + 2 * 8 * 3 * 256;
constexpr size_t O_PSCONV = O_PLH + 2 * 8 * 256;
constexpr size_t O_PSH = O_PSCONV + 2 * 8 * 3 * 768;
constexpr size_t O_SK = O_PSH + (size_t)2 * 8 * 32768;
constexpr size_t O_SV = O_SK + (size_t)2 * TS * 512;
constexpr size_t O_SLOGF = O_SV + (size_t)2 * TS * 512;
constexpr size_t O_SLCONV = O_SLOGF + 2 * TS * 8;
constexpr size_t O_SLH = O_SLCONV + 2 * 16 * 3 * 256;
constexpr size_t O_SSCONV = O_SLH + 2 * 16 * 256;
constexpr size_t O_SSH = O_SSCONV + 2 * 16 * 3 * 768;

constexpr size_t al256(size_t x) { return (x + 255) & ~(size_t)255; }
constexpr size_t W_GU = 0;
constexpr size_t W_D = al256(W_GU + (size_t)4 * NGU * DM * 2);
constexpr size_t W_IN = al256(W_D + (size_t)4 * DM * DFF * 2);
constexpr size_t W_OUT = al256(W_IN + (size_t)2 * NIN * DM * 2);
constexpr size_t W_MOD = al256(W_OUT + (size_t)2 * DM * DM * 2);
constexpr size_t W_FC = al256(W_MOD + (size_t)2 * NSEQ * 9216 * 4);
constexpr size_t W_X = al256(W_FC + (size_t)2 * 16 * 4096 * 8 * 4);
constexpr size_t W_H = al256(W_X + (size_t)TT * DM * 4);
constexpr size_t W_ACT = al256(W_H + (size_t)TT * DM * 2);
constexpr size_t W_Y = al256(W_ACT + (size_t)TT * DFF * 2);
constexpr size_t W_PROJ = al256(W_Y + (size_t)TT * DM * 4);
constexpr size_t W_QB = al256(W_PROJ + (size_t)TT * NIN * 4);
constexpr size_t W_KB = al256(W_QB + (size_t)TT * 512 * 2);
constexpr size_t W_VB = al256(W_KB + (size_t)TT * 512 * 2);
constexpr size_t W_MIX = al256(W_VB + (size_t)TT * 512 * 2);
constexpr size_t W_HLOC = al256(W_MIX + (size_t)TT * DM * 2);
constexpr size_t W_ACUM = al256(W_HLOC + (size_t)TT * 256 * 4);
constexpr size_t W_AGGA = al256(W_ACUM + (size_t)TT * 256 * 4);
constexpr size_t W_AGGB = al256(W_AGGA + (size_t)NCI * 256 * 4);
constexpr size_t W_XACT = al256(W_AGGB + (size_t)NCI * 256 * 4);
constexpr size_t W_DTB = al256(W_XACT + (size_t)TT * 768 * 4);
constexpr size_t W_CUMB = al256(W_DTB + (size_t)TT * 4 * 4);
constexpr size_t W_STATES = al256(W_CUMB + (size_t)TT * 4 * 4);
constexpr size_t W_CDEC = al256(W_STATES + (size_t)NCI * 32768 * 4);
constexpr size_t W_YBUF = al256(W_CDEC + (size_t)NCI * 4 * 4);
constexpr size_t W_PO = al256(W_YBUF + (size_t)TT * 256 * 4);
constexpr size_t W_PM = al256(W_PO + (size_t)1024 * 32 * 64 * 4);
constexpr size_t W_PL = al256(W_PM + (size_t)1024 * 32 * 4);
constexpr size_t W_YS = al256(W_PL + (size_t)1024 * 32 * 4);
constexpr size_t W_X2 = al256(W_YS + (size_t)11 * TS * DM * 4);
constexpr size_t W_XB16 = al256(W_X2 + (size_t)TT * DM * 4);
constexpr size_t W_HS16 = al256(W_XB16 + (size_t)TT * 512 * 2);
constexpr size_t W_BAR = al256(W_HS16 + (size_t)256 * 32768 * 2);
constexpr size_t W_END = al256(W_BAR + (size_t)4096 * 4);

struct Params {
    const float* in[34];
    float* out;
    unsigned char* ws;
    int ph_lo, ph_hi;
};
enum { I_XP = 0, I_XS, I_CP, I_CS, I_CK, I_CV, I_CLOGF, I_SLCONV, I_SLH, I_SSCONV, I_SSH, I_WMOD, I_BMOD, I_NPRE, I_NPOST, I_WG, I_WU, I_WD, I_WIN, I_WOUT,
       I_LCW, I_LCB, I_LWA, I_LBA, I_LWX, I_LBX, I_LLAM, I_FBIAS, I_SCW, I_SCB, I_SDTB, I_SALOG, I_SD, I_SNW };

__device__ __forceinline__ int fresh_tid() { int t = threadIdx.x; asm volatile("" : "+v"(t)); return t; }
__device__ __forceinline__ unsigned cvt_pk_bf16(float lo, float hi) { unsigned r; asm volatile("v_cvt_pk_bf16_f32 %0, %1, %2" : "=v"(r) : "v"(lo), "v"(hi)); return r; }
__device__ __forceinline__ bf16_t f2bf(float f) { return (bf16_t)(cvt_pk_bf16(f, 0.f) & 0xffffu); }
__device__ __forceinline__ float wave_sum(float v) {
#pragma unroll
    for (int o = 32; o > 0; o >>= 1) v += __shfl_xor(v, o);
    return v;
}
__device__ __forceinline__ float sigmoid_f(float x) { return __builtin_amdgcn_rcpf(1.f + __expf(-x)); }
__device__ __forceinline__ float silu_f(float x) { return x * __builtin_amdgcn_rcpf(1.f + __expf(-x)); }
__device__ __forceinline__ float softplus_f(float x) { return fmaxf(x, 0.f) + log1pf(__expf(-fabsf(x))); }
__device__ __forceinline__ float logsigmoid_f(float x) { return fminf(x, 0.f) - log1pf(__expf(-fabsf(x))); }
__device__ __forceinline__ float gelu_tanh_f(float x) { const float u = 0.7978845608028654f * (x + 0.044715f * x * x * x); return x * sigmoid_f(2.f * u); }
__device__ __forceinline__ int seq_of_row(int r) { return r < TP ? (r >> 11) : 8 + ((r - TP) >> 5); }


#define XB_TMO      128
#define XB_XCNT(j)  (256  + 64 * (j))
#define XB_XSUB(j)  (1280 + 64 * (j))
#define XB_XGEN(j)  (2304 + 64 * (j))
#define XB_TOP      3328
#define XB_TOPGEN   3392
#define XCD_BAR_WORDS 3456
#define XB_SPIN_CAP (1u << 22)
__device__ __forceinline__ unsigned xb_ld(unsigned* p)              { return __hip_atomic_load(p, __ATOMIC_RELAXED, __HIP_MEMORY_SCOPE_AGENT); }
__device__ __forceinline__ unsigned xb_add(unsigned* p, unsigned v) { return __hip_atomic_fetch_add(p, v, __ATOMIC_RELAXED, __HIP_MEMORY_SCOPE_AGENT); }
__device__ __forceinline__ unsigned xb_xcc_id() { return (unsigned)__builtin_amdgcn_s_getreg((3 << 11) | 20) & 0xFu; }
#define XB_SPIN(cond, bar) do { unsigned _sp = 0; while (cond) { __builtin_amdgcn_s_sleep(1); \
    if ((++_sp & 255u) == 0u) { if (xb_ld(&(bar)[XB_TMO])) break; if (_sp > XB_SPIN_CAP) { atomicAdd(&(bar)[XB_TMO], 1u); break; } } } } while (0)
struct XcdBarrier { unsigned* bar; unsigned x; volatile LAS unsigned* st; };
__device__ __forceinline__ XcdBarrier xcd_barrier_post(unsigned* bar, volatile LAS unsigned* st) {
    XcdBarrier b; b.bar = bar; b.x = xb_xcc_id(); b.st = st;
    if (threadIdx.x == 0) (void)xb_add(&bar[XB_XCNT(b.x)], 1u);
    return b;
}
__device__ __forceinline__ void xcd_barrier_complete(unsigned* bar, unsigned x, unsigned& nloc, unsigned& nx) {
    const unsigned G = gridDim.x * gridDim.y * gridDim.z;
    unsigned sum, cnt, mine, sp = 0u;
    for (;;) {
        sum = 0u; cnt = 0u; mine = 0u;
#pragma unroll
        for (unsigned j = 0; j < 16; ++j) { const unsigned c = xb_ld(&bar[XB_XCNT(j)]); sum += c; cnt += (c > 0u) ? 1u : 0u; mine = (j == x) ? c : mine; }
        if (sum == G) break;
        __builtin_amdgcn_s_sleep(1);
        if ((++sp & 255u) == 0u) { if (xb_ld(&bar[XB_TMO])) break; if (sp > XB_SPIN_CAP) { atomicAdd(&bar[XB_TMO], 1u); break; } }
    }
    nloc = mine > 0u ? mine : 1u; nx = cnt > 0u ? cnt : 1u;
}
__device__ __forceinline__ void xcd_barrier(const XcdBarrier& b) {
    asm volatile("s_waitcnt vmcnt(0)" ::: "memory");
    __syncthreads();
    if (threadIdx.x == 0) {
        unsigned* bar = b.bar;
        __builtin_amdgcn_s_waitcnt(0);
        unsigned nloc = b.st[0], nx = b.st[1];
        if (nloc == 0u) { xcd_barrier_complete(bar, b.x, nloc, nx); b.st[0] = nloc; b.st[1] = nx; }
        const unsigned old = xb_add(&bar[XB_XSUB(b.x)], 1u);
        const unsigned gen = old / nloc;
        if (old + 1u == (gen + 1u) * nloc) {
            __builtin_amdgcn_fence(__ATOMIC_RELEASE, "agent");
            asm volatile("s_waitcnt vmcnt(0)" ::: "memory");
            const unsigned og = xb_add(&bar[XB_TOP], 1u);
            const unsigned tg = og / nx;
            if (og + 1u == (tg + 1u) * nx) xb_add(&bar[XB_TOPGEN], 1u);
            else XB_SPIN(xb_ld(&bar[XB_TOPGEN]) == tg, bar);
            __builtin_amdgcn_fence(__ATOMIC_ACQUIRE, "agent");
            xb_add(&bar[XB_XGEN(b.x)], 1u);
            asm volatile("s_waitcnt vmcnt(0)" ::: "memory");
        } else {
            XB_SPIN(xb_ld(&bar[XB_XGEN(b.x)]) == gen, bar);
            __builtin_amdgcn_fence(__ATOMIC_ACQUIRE, "agent");
            asm volatile("s_waitcnt vmcnt(0)" ::: "memory");
        }
    }
    __syncthreads();
}

struct CItem { int seq, c, L, row0, b; bool prompt, lastc; };
__device__ __forceinline__ CItem citem(int ci) {
    CItem it;
    if (ci < 256) { it.prompt = true; it.seq = ci >> 5; it.c = ci & 31; it.L = 64; it.row0 = it.seq * 2048 + it.c * 64; it.b = it.seq; it.lastc = (it.c == 31); }
    else { it.prompt = false; it.b = ci - 256; it.seq = 8 + it.b; it.c = 0; it.L = 32; it.row0 = TP + it.b * 32; it.lastc = true; }
    return it;
}

namespace pg8 {
constexpr int BM = 256, BK = 64, HALF = 128, HTB = HALF * BK * 2, STAGE_BYTES = 8 * HTB, NXCD = 8, WGM = 4;
__device__ __forceinline__ int lds_byte(int r, int c) { const int st = (r >> 4) * 2 + (c >> 5), rr = r & 15, cc = c & 31, ob = rr * 64 + cc * 2; return st * 1024 + (ob ^ (((ob >> 9) & 1) << 5)); }
__device__ __forceinline__ void stage_rc(int b, int& R, int& C) { const int st = b / 1024, sb = b % 1024, swz = sb ^ (((sb >> 9) & 1) << 5); R = (st >> 1) * 16 + swz / 64; C = (st & 1) * 32 + (swz % 64) / 2; }
__device__ __forceinline__ int perm32(int rho) { const int n = rho >> 4, i = rho & 15; return 8 * (i >> 2) + 4 * n + (i & 3); }
struct Unit { int pm, pn, k0, nt, slab; };
struct Gemm { const bf16_t* A; const bf16_t* Bt; int lda, ldb; };
struct StaticOrder {
    int nM, nN, nwg, G, c, ntk;
    __device__ void init(int M, int N, int K, int G_, int c_) { nM = M / BM; nN = N / BM; nwg = nM * nN; G = G_; c = c_; ntk = K / BK; }
    __device__ bool next(int i, Unit& u) const {
        const long L = (long)i * G + c; if (L >= nwg) return false;
        int wgid = (int)L; { const int q = nwg / NXCD, r = nwg % NXCD, xcd = wgid % NXCD, off = wgid / NXCD; wgid = (xcd < r ? xcd * (q + 1) : r * (q + 1) + (xcd - r) * q) + off; }
        const int nig = WGM * nN, gid = wgid / nig, fm = gid * WGM, gsz = (nM - fm) < WGM ? (nM - fm) : WGM;
        u.pm = fm + ((wgid % nig) % gsz); u.pn = (wgid % nig) / gsz; u.k0 = 0; u.nt = ntk; u.slab = 0; return true;
    }
    __device__ __forceinline__ void a_ready(const Unit&) const {}
    __device__ __forceinline__ void done(const Unit&) const {}
};

struct SampleSplitOrder {
    StaticOrder P; int nslice;
    __device__ void init(int N, int K, int G_, int c_) { P.init(TP, N, K, G_, c_); nslice = K / 256; }
    __device__ bool next(int i, Unit& u) const {
        const long L = (long)i * P.G + P.c;
        if (L < P.nwg) return P.next(i, u);
        const int e = (int)(L - P.nwg); if (e >= 2 * P.nN * nslice) return false;
        const int tile = e / nslice, s = e % nslice; u.pm = 64 + tile / P.nN; u.pn = tile % P.nN; u.k0 = s * 256; u.nt = 4; u.slab = s; return true;
    }
    __device__ __forceinline__ void a_ready(const Unit&) const {}
    __device__ __forceinline__ void done(const Unit&) const {}
};

struct EpiF32 {
    static constexpr bool PERM = false;
    float* C; float* S; int ldc;
    __device__ __forceinline__ void operator()(const f32x4 (&acc)[2][2][4][2], const Unit& u, int wr, int wc, int fr, int fq) const {
        const int row0 = u.pm * BM + wr * 64 + fr, col0 = u.pn * BM + wc * 32 + 4 * fq;
        float* base = u.pm >= 64 ? S + ((long)u.slab * TS - TP) * (long)ldc : C;
#pragma unroll
        for (int ai = 0; ai < 2; ++ai)
#pragma unroll
            for (int m = 0; m < 4; ++m) { float* rowp = base + (size_t)(row0 + ai * HALF + m * 16) * ldc + col0;
#pragma unroll
                for (int bj = 0; bj < 2; ++bj)
#pragma unroll
                    for (int n = 0; n < 2; ++n) *(f32x4*)(rowp + bj * HALF + n * 16) = acc[ai][bj][m][n]; }
    }
};
struct EpiY {
    static constexpr bool PERM = true;
    bf16_t* C; float* S;
    __device__ __forceinline__ void operator()(const f32x4 (&acc)[2][2][4][2], const Unit& u, int wr, int wc, int fr, int fq) const {
        const int row0 = u.pm * BM + wr * 64 + fr, col0 = u.pn * BM + wc * 32 + 8 * fq;
        if (u.pm < 64) {
#pragma unroll
            for (int ai = 0; ai < 2; ++ai)
#pragma unroll
                for (int m = 0; m < 4; ++m) { bf16_t* rowp = C + (size_t)(row0 + ai * HALF + m * 16) * DM + col0;
#pragma unroll
                    for (int bj = 0; bj < 2; ++bj) { const f32x4 v0 = acc[ai][bj][m][0], v1 = acc[ai][bj][m][1];
                        u32x4 w; w.x = cvt_pk_bf16(v0[0], v0[1]); w.y = cvt_pk_bf16(v0[2], v0[3]); w.z = cvt_pk_bf16(v1[0], v1[1]); w.w = cvt_pk_bf16(v1[2], v1[3]);
                        *(u32x4*)(rowp + bj * HALF) = w; } }
        } else {
            float* base = S + ((long)u.slab * TS - TP) * (long)DM;
#pragma unroll
            for (int ai = 0; ai < 2; ++ai)
#pragma unroll
                for (int m = 0; m < 4; ++m) { float* rowp = base + (size_t)(row0 + ai * HALF + m * 16) * DM + col0;
#pragma unroll
                    for (int bj = 0; bj < 2; ++bj) { *(f32x4*)(rowp + bj * HALF) = acc[ai][bj][m][0]; *(f32x4*)(rowp + bj * HALF + 4) = acc[ai][bj][m][1]; } }
        }
    }
};
struct EpiGU {
    static constexpr bool PERM = true;
    bf16_t* O;
    __device__ __forceinline__ void operator()(const f32x4 (&acc)[2][2][4][2], const Unit& u, int wr, int wc, int fr, int fq) const {
        const int row0 = u.pm * BM + wr * 64 + fr, col0 = u.pn * HALF + wc * 32 + 8 * fq;
#pragma unroll
        for (int ai = 0; ai < 2; ++ai)
#pragma unroll
            for (int m = 0; m < 4; ++m) { bf16_t* rowp = O + (size_t)(row0 + ai * HALF + m * 16) * DFF + col0;
                float v[8];
#pragma unroll
                for (int n = 0; n < 2; ++n)
#pragma unroll
                    for (int j = 0; j < 4; ++j) { const float gt = acc[ai][0][m][n][j], up = acc[ai][1][m][n][j]; v[n * 4 + j] = silu_f(gt) * up; }
                u32x4 w; w.x = cvt_pk_bf16(v[0], v[1]); w.y = cvt_pk_bf16(v[2], v[3]); w.z = cvt_pk_bf16(v[4], v[5]); w.w = cvt_pk_bf16(v[6], v[7]);
                *(u32x4*)rowp = w; }
    }
};
struct EpiIn {
    static constexpr bool PERM = false;
    float* proj; bf16_t* qb; bf16_t* kb; bf16_t* vb; float* kp; float* ks; float* vp; float* vs;
    __device__ __forceinline__ void operator()(const f32x4 (&acc)[2][2][4][2], const Unit& u, int wr, int wc, int fr, int fq) const {
        const int row0 = u.pm * BM + wr * 64 + fr; const int pn = u.pn;
        if (pn < 2 || pn >= 8) {
            const int col0 = pn * BM + wc * 32 + 4 * fq;
#pragma unroll
            for (int ai = 0; ai < 2; ++ai)
#pragma unroll
                for (int m = 0; m < 4; ++m) { float* rowp = proj + (size_t)(row0 + ai * HALF + m * 16) * NIN + col0;
#pragma unroll
                    for (int bj = 0; bj < 2; ++bj)
#pragma unroll
                        for (int n = 0; n < 2; ++n) *(f32x4*)(rowp + bj * HALF + n * 16) = acc[ai][bj][m][n]; }
        } else if (pn < 4) {
            const int col0 = (pn - 2) * BM + wc * 32 + 4 * fq;
#pragma unroll
            for (int ai = 0; ai < 2; ++ai)
#pragma unroll
                for (int m = 0; m < 4; ++m) { bf16_t* rowp = qb + (size_t)(row0 + ai * HALF + m * 16) * 512 + col0;
#pragma unroll
                    for (int bj = 0; bj < 2; ++bj)
#pragma unroll
                        for (int n = 0; n < 2; ++n) { const f32x4 a = acc[ai][bj][m][n]; u32x2 w; w.x = cvt_pk_bf16(a[0], a[1]); w.y = cvt_pk_bf16(a[2], a[3]); *(u32x2*)(rowp + bj * HALF + n * 16) = w; } }
        } else {
            const bool isk = pn < 6; const int col0 = ((pn - 4) & 1) * BM + wc * 32 + 4 * fq;
            bf16_t* bb = isk ? kb : vb; float* fp = isk ? kp : vp; float* fs = isk ? ks : vs;
#pragma unroll
            for (int ai = 0; ai < 2; ++ai)
#pragma unroll
                for (int m = 0; m < 4; ++m) { const int row = row0 + ai * HALF + m * 16;
                    bf16_t* rowp = bb + (size_t)row * 512 + col0;
                    float* rowf = (row < TP ? fp + (size_t)row * 512 : fs + (size_t)(row - TP) * 512) + col0;
#pragma unroll
                    for (int bj = 0; bj < 2; ++bj)
#pragma unroll
                        for (int n = 0; n < 2; ++n) { const f32x4 a = acc[ai][bj][m][n]; u32x2 w; w.x = cvt_pk_bf16(a[0], a[1]); w.y = cvt_pk_bf16(a[2], a[3]);
                            *(u32x2*)(rowp + bj * HALF + n * 16) = w; *(f32x4*)(rowf + bj * HALF + n * 16) = a; } }
        }
    }
};

template <class Epi, class Sched>
__device__ __forceinline__ void gemm_phase(LAS unsigned char* lds, const Gemm g, const Sched& S, const Epi& E) {
    const int tid = fresh_tid(), wid = __builtin_amdgcn_readfirstlane(tid >> 6), lane = tid & 63, wr = wid >> 2, wc = wid & 3, fr = lane & 15, fq = lane >> 4;
    const int lda = g.lda, ldb = g.ldb;
    unsigned voffA[2], voffB[2];
#pragma unroll
    for (int i = 0; i < 2; ++i) { int R, C; stage_rc(tid * 16 + i * 8192, R, C); const int Rb = Epi::PERM ? ((R & ~31) + perm32(R & 31)) : R;
        voffA[i] = (unsigned)(R * lda + C) * 2u; voffB[i] = (unsigned)(Rb * ldb + C) * 2u; }
    const size_t kstep = (size_t)(BK * 2);
    const size_t hstepA = (size_t)HALF * lda * 2, hstepB = (size_t)HALF * ldb * 2;
    const size_t tstepA = 2 * hstepA, tstepB = 2 * hstepB;
    const unsigned ldsw = (unsigned)wid * 1024u;
    const int aoff = lds_byte(wr * 64 + fr, fq * 8), boff = lds_byte(wc * 32 + fr, fq * 8);
#define PG8_SA(b, h) (((b) * 2 + (h)) * HTB)
#define PG8_SB(b, h) ((4 + (b) * 2 + (h)) * HTB)
#define PG8_STAGE(bufoff, gbase, voff) do { _Pragma("unroll") for (int _i = 0; _i < 2; ++_i) \
        __builtin_amdgcn_global_load_lds((const unsigned*)((const char*)(gbase) + (voff)[_i]), (LAS unsigned*)(lds + (bufoff) + ldsw + _i * 8192), 16, 0, 0); } while (0)
#define PG8_LDA(dst, b, h) do { _Pragma("unroll") for (int m = 0; m < 4; ++m) _Pragma("unroll") for (int k = 0; k < 2; ++k) dst[m][k] = *(const LAS bf16x8*)(lds + PG8_SA(b, h) + aoff + m * 2048 + k * 1024); } while (0)
#define PG8_LDB(dst, b, h) do { _Pragma("unroll") for (int n = 0; n < 2; ++n) _Pragma("unroll") for (int k = 0; k < 2; ++k) dst[n][k] = *(const LAS bf16x8*)(lds + PG8_SB(b, h) + boff + n * 2048 + k * 1024); } while (0)
#define PG8_MMA(ai, bj, At, Bt) do { __builtin_amdgcn_s_setprio(1); _Pragma("unroll") for (int m = 0; m < 4; ++m) _Pragma("unroll") for (int n = 0; n < 2; ++n) _Pragma("unroll") for (int k = 0; k < 2; ++k) \
        acc[ai][bj][m][n] = __builtin_amdgcn_mfma_f32_16x16x32_bf16(Bt[n][k], At[m][k], acc[ai][bj][m][n], 0, 0, 0); __builtin_amdgcn_s_setprio(0); } while (0)
#define PG8_WAIT_V(n) asm volatile("s_waitcnt vmcnt(" #n ")" ::: "memory")
#define PG8_WAIT_L(n) asm volatile("s_waitcnt lgkmcnt(" #n ")" ::: "memory")
#define PG8_BAR __builtin_amdgcn_s_barrier()
#define PG8_SCHED __builtin_amdgcn_sched_barrier(0)
    Unit cur, nxt; int ui = 0;
    if (!S.next(0, cur)) return;
    f32x4 acc[2][2][4][2];
#pragma unroll
    for (int a = 0; a < 2; ++a)
#pragma unroll
        for (int b = 0; b < 2; ++b)
#pragma unroll
            for (int m = 0; m < 4; ++m)
#pragma unroll
                for (int n = 0; n < 2; ++n) acc[a][b][m][n] = (f32x4){0.f, 0.f, 0.f, 0.f};
    bf16x8 At[4][2], B0[2][2], B1[2][2];
    const char* cA = (const char*)g.A + (size_t)cur.pm * tstepA + (size_t)cur.k0 * 2; const char* cB = (const char*)g.Bt + (size_t)cur.pn * tstepB + (size_t)cur.k0 * 2;
    S.a_ready(cur);
    PG8_STAGE(PG8_SB(0, 0), cB, voffB); PG8_STAGE(PG8_SA(0, 0), cA, voffA); PG8_STAGE(PG8_SB(0, 1), cB + hstepB, voffB); PG8_STAGE(PG8_SA(0, 1), cA + hstepA, voffA);
    if (wr == 1) PG8_BAR;
    PG8_WAIT_V(4); PG8_BAR;
    PG8_STAGE(PG8_SB(1, 0), cB + kstep, voffB); PG8_STAGE(PG8_SA(1, 0), cA + kstep, voffA); PG8_STAGE(PG8_SB(1, 1), cB + hstepB + kstep, voffB);
    PG8_WAIT_V(6); PG8_BAR;
    for (;;) {
        const bool has_next = S.next(ui + 1, nxt);
        const char* nA = has_next ? (const char*)g.A + (size_t)nxt.pm * tstepA + (size_t)nxt.k0 * 2 : cA; const char* nB = has_next ? (const char*)g.Bt + (size_t)nxt.pn * tstepB + (size_t)nxt.k0 * 2 : cB;
        const int nt = cur.nt;
        for (int t = 0; t < nt; t += 2) {
            const bool last = (t == nt - 2);
            const char* a1 = cA + (size_t)(t + 1) * kstep;
            const char* a2 = last ? nA : cA + (size_t)(t + 2) * kstep; const char* b2 = last ? nB : cB + (size_t)(t + 2) * kstep;
            const char* a3 = a2 + kstep; const char* b3 = b2 + kstep;
            if (last && has_next) S.a_ready(nxt);
            PG8_LDB(B0, 0, 0); PG8_SCHED; PG8_LDA(At, 0, 0); PG8_STAGE(PG8_SA(1, 1), a1 + hstepA, voffA);
            PG8_WAIT_L(8); PG8_BAR; PG8_WAIT_L(0); PG8_MMA(0, 0, At, B0); PG8_BAR; PG8_SCHED;
            PG8_LDB(B1, 0, 1); PG8_STAGE(PG8_SB(0, 0), b2, voffB);
            PG8_BAR; PG8_WAIT_L(0); PG8_MMA(0, 1, At, B1); PG8_BAR;
            PG8_LDA(At, 0, 1); PG8_STAGE(PG8_SA(0, 0), a2, voffA);
            PG8_BAR; PG8_WAIT_L(0); PG8_MMA(1, 0, At, B0); PG8_BAR; PG8_SCHED;
            PG8_STAGE(PG8_SB(0, 1), b2 + hstepB, voffB);
            PG8_WAIT_V(6); PG8_BAR; PG8_MMA(1, 1, At, B1); PG8_BAR;
            PG8_LDB(B0, 1, 0); PG8_SCHED; PG8_LDA(At, 1, 0); PG8_STAGE(PG8_SA(0, 1), a2 + hstepA, voffA);
            PG8_WAIT_L(8); PG8_BAR; PG8_WAIT_L(0); PG8_MMA(0, 0, At, B0); PG8_BAR; PG8_SCHED;
            PG8_LDB(B1, 1, 1); PG8_STAGE(PG8_SB(1, 0), b3, voffB);
            PG8_BAR; PG8_WAIT_L(0); PG8_MMA(0, 1, At, B1); PG8_BAR;
            PG8_LDA(At, 1, 1); PG8_STAGE(PG8_SA(1, 0), a3, voffA);
            PG8_BAR; PG8_WAIT_L(0); PG8_MMA(1, 0, At, B0); PG8_BAR; PG8_SCHED;
            PG8_STAGE(PG8_SB(1, 1), b3 + hstepB, voffB);
            PG8_WAIT_V(6); PG8_BAR; PG8_MMA(1, 1, At, B1); PG8_BAR;
        }
        E(acc, cur, wr, wc, fr, fq); S.done(cur);
        if (!has_next) break;
#pragma unroll
        for (int a = 0; a < 2; ++a)
#pragma unroll
            for (int b = 0; b < 2; ++b)
#pragma unroll
                for (int m = 0; m < 4; ++m)
#pragma unroll
                    for (int n = 0; n < 2; ++n) acc[a][b][m][n] = (f32x4){0.f, 0.f, 0.f, 0.f};
        cur = nxt; cA = nA; cB = nB; ++ui;
    }
    PG8_WAIT_V(0);
    if (wr == 0) PG8_BAR;
    PG8_BAR;
#undef PG8_SA
#undef PG8_SB
#undef PG8_STAGE
#undef PG8_LDA
#undef PG8_LDB
#undef PG8_MMA
#undef PG8_WAIT_V
#undef PG8_WAIT_L
#undef PG8_BAR
#undef PG8_SCHED
}
}

constexpr int NTR_GU = 4 * 88 * 4, NTR_D = 4 * 16 * 11, NTR_IN = 2 * 52 * 4, NTR_OUT = 2 * 16 * 4, NTR = NTR_GU + NTR_D + NTR_IN + NTR_OUT;
constexpr int WT_D = NTR_GU, WT_IN = NTR_GU + NTR_D, WT_OUT = NTR_GU + NTR_D + NTR_IN;
__device__ __forceinline__ void wtile(const Params& p, LAS float* fl, int tid, int tr) {
            const float* src; bf16_t* dst; int K, ldsrc, ntile, kt;
            const int n4 = (tid & 15) * 4, kr = tid >> 4;
            if (tr < NTR_GU) { const int lf = tr / 352, rem = tr % 352; ntile = rem / 4; kt = rem % 4; dst = (bf16_t*)(p.ws + W_GU) + (size_t)lf * NGU * DM; K = DM; ldsrc = DFF;
                const int np = ntile * 64 + n4; const int col = (np >> 8) * 128 + (np & 127); src = ((np >> 7) & 1 ? p.in[I_WU] : p.in[I_WG]) + (size_t)lf * DM * DFF + col; }
            else if (tr < NTR_GU + NTR_D) { tr -= NTR_GU; const int lf = tr / 176, rem = tr % 176; ntile = rem / 11; kt = rem % 11; dst = (bf16_t*)(p.ws + W_D) + (size_t)lf * DM * DFF; K = DFF; ldsrc = DM;
                src = p.in[I_WD] + (size_t)lf * DFF * DM + ntile * 64 + n4; }
            else if (tr < NTR_GU + NTR_D + NTR_IN) { tr -= NTR_GU + NTR_D; const int l = tr / 208, rem = tr % 208; ntile = rem / 4; kt = rem % 4; dst = (bf16_t*)(p.ws + W_IN) + (size_t)l * NIN * DM; K = DM; ldsrc = DIN;
                const int np = ntile * 64 + n4; const int col = np < 2048 ? np : (np < 3072 ? np + 8 : (np < 3080 ? np - 1024 : (np < 3084 ? np : -1)));
                src = col >= 0 ? p.in[I_WIN] + (size_t)l * DM * DIN + col : nullptr; }
            else { tr -= NTR_GU + NTR_D + NTR_IN; const int l = tr / 64, rem = tr % 64; ntile = rem / 4; kt = rem % 4; dst = (bf16_t*)(p.ws + W_OUT) + (size_t)l * DM * DM; K = DM; ldsrc = DM;
                src = p.in[I_WOUT] + (size_t)l * DM * DM + ntile * 64 + n4; }
            const int k0 = kt * 256;
            f32x4 v[8];
            const float* sb = src ? src + (size_t)(k0 + kr) * ldsrc : nullptr;
#pragma unroll
            for (int i = 0; i < 8; ++i) v[i] = sb ? *(const f32x4*)(sb + (size_t)(32 * i) * ldsrc) : (f32x4){0.f, 0.f, 0.f, 0.f};
#pragma unroll
            for (int i = 0; i < 8; ++i) { LAS float* d = fl + (kr + 32 * i) * 65 + n4; d[0] = v[i][0]; d[1] = v[i][1]; d[2] = v[i][2]; d[3] = v[i][3]; }
            __syncthreads();
            const int nl = tid >> 3;
#pragma unroll
            for (int r = 0; r < 4; ++r) { const int kseg = (tid & 7) * 8 + r * 64; float o[8];
#pragma unroll
                for (int j = 0; j < 8; ++j) o[j] = fl[(kseg + j) * 65 + nl];
                u32x4 w; w.x = cvt_pk_bf16(o[0], o[1]); w.y = cvt_pk_bf16(o[2], o[3]); w.z = cvt_pk_bf16(o[4], o[5]); w.w = cvt_pk_bf16(o[6], o[7]);
                *(u32x4*)(dst + (size_t)(ntile * 64 + nl) * K + k0 + kseg) = w; }
            __syncthreads();
}
__device__ __forceinline__ void wconv(const Params& p, LAS unsigned char* lds, int lo0, int n0, int lo1, int n1, int lo2, int n2, int rel, int stride) {
    const int tid = fresh_tid();
    for (int v = rel; v < n0 + n1 + n2; v += stride) { const int tr = v < n0 ? lo0 + v : (v < n0 + n1 ? lo1 + (v - n0) : lo2 + (v - n0 - n1)); wtile(p, (LAS float*)lds, tid, tr); }
}
__device__ __forceinline__ void prep_phase(const Params& p, LAS unsigned char* lds, int bid, int nb) {
    const int tid = fresh_tid();
    LAS float* fl = (LAS float*)lds;
    bool sc_ready = false;
    for (int it = bid; it < 320 + 352; it += nb) {
        if (it < 288) {
            LAS float* sc = fl; LAS float* red = fl + 24 * 1024;
            if (!sc_ready) {
                for (int i = tid; i < 24 * 1024; i += 512) { const int s = i >> 10, k = i & 1023; const float c = s < 8 ? p.in[I_CP][s * 1024 + k] : p.in[I_CS][(s - 8) * 1024 + k]; sc[i] = silu_f(c); }
                __syncthreads(); sc_ready = true;
            }
            const int l = it / 144, c0 = (it % 144) * 64, cq = (tid & 15) * 4, kg = tid >> 4;
            f32x4 acc[24];
#pragma unroll
            for (int s = 0; s < 24; ++s) acc[s] = (f32x4){0.f, 0.f, 0.f, 0.f};
            const float* w = p.in[I_WMOD] + (size_t)l * 1024 * 9216 + c0 + cq + (size_t)(kg * 32) * 9216;
#pragma unroll 1
            for (int kb = 0; kb < 32; kb += 8) {
                f32x4 wv[8];
#pragma unroll
                for (int i = 0; i < 8; ++i) wv[i] = *(const f32x4*)(w + (size_t)(kb + i) * 9216);
#pragma unroll
                for (int i = 0; i < 8; i += 4) {
#pragma unroll
                    for (int s = 0; s < 24; ++s) { const f32x4 c4 = *(const LAS f32x4*)(sc + s * 1024 + kg * 32 + kb + i); acc[s] += c4[0] * wv[i] + c4[1] * wv[i + 1] + c4[2] * wv[i + 2] + c4[3] * wv[i + 3]; } }
            }
#pragma unroll
            for (int s = 0; s < 24; ++s) {
#pragma unroll
                for (int c = 0; c < 4; ++c) { float a = acc[s][c]; a += __shfl_xor(a, 16); a += __shfl_xor(a, 32); acc[s][c] = a; } }
            if ((tid & 63) < 16) { const int wv8 = tid >> 6;
#pragma unroll
                for (int s = 0; s < 24; ++s) *(LAS f32x4*)(red + (wv8 * 24 + s) * 64 + cq) = acc[s]; }
            __syncthreads();
            float* mod = (float*)(p.ws + W_MOD);
            for (int i = tid; i < 24 * 64; i += 512) { const int s = i >> 6, cc = i & 63; float sum = p.in[I_BMOD][l * 9216 + c0 + cc];
                for (int k2 = 0; k2 < 8; ++k2) sum += red[(k2 * 24 + s) * 64 + cc];
                mod[(size_t)(l * 24 + s) * 9216 + c0 + cc] = sum; }
            __syncthreads();
        } else if (it < 320) {
            const int idx = it - 288;
            const float* base = p.in[I_CLOGF] + (size_t)idx * 4096 * 8; float* fc = (float*)(p.ws + W_FC) + (size_t)idx * 4096 * 8;
            const int head = tid & 7, seg = tid >> 3;
            const float* bp = base + (seg * 64) * 8 + head; float* fp = fc + (seg * 64) * 8 + head;
            float run = 0.f;
            for (int i0 = 0; i0 < 64; i0 += 16) { float v[16];
#pragma unroll
                for (int i = 0; i < 16; ++i) v[i] = bp[(i0 + i) * 8];
#pragma unroll
                for (int i = 0; i < 16; ++i) { run += v[i]; fp[(i0 + i) * 8] = run; } }
            __syncthreads();
            fl[seg * 8 + head] = run;
            __syncthreads();
            float off = 0.f; for (int s2 = 0; s2 < seg; ++s2) off += fl[s2 * 8 + head];
            for (int i0 = 0; i0 < 64; i0 += 16) { float v[16];
#pragma unroll
                for (int i = 0; i < 16; ++i) v[i] = fp[(i0 + i) * 8];
#pragma unroll
                for (int i = 0; i < 16; ++i) fp[(i0 + i) * 8] = v[i] + off; }
            __syncthreads();
        } else {
            wtile(p, fl, tid, it - 320);
        }
    }
}

__device__ __forceinline__ void norm_phase(const Params& p, bool first, bool last, int lpost, int jpost, float wpost, int lpre, int jpre, int nslab, int xsel, int bid, int nb) {
    const int tid = fresh_tid(), wave = tid >> 6, lane = tid & 63;
    const bf16_t* xrd = (const bf16_t*)(p.ws + (xsel ? W_X2 : W_X)); bf16_t* xws = (bf16_t*)(p.ws + (xsel ? W_X : W_X2));
    const bf16_t* Y = (const bf16_t*)(p.ws + W_Y); bf16_t* H = (bf16_t*)(p.ws + W_H); const float* mod = (const float*)(p.ws + W_MOD);
    for (int pass = 0; pass < 2; ++pass) {
        const int cstart = pass == 0 ? (bid * 8 + wave) * 8 : (wave < 2 ? TP + bid * 2 + wave : TT), cstride = pass == 0 ? nb * 64 : nb * 2, climit = pass == 0 ? TP : TT, nrow = pass == 0 ? 8 : 1;
        for (int rbase = cstart; rbase < climit; rbase += cstride) {
        const int seq = seq_of_row(rbase);
        f32x4 Av[4], Bv[4], Cv[4];
        if (!first) { const float* gate = mod + (size_t)(lpost * 24 + seq) * 9216 + jpost * 3072 + 2048; const float* gp = p.in[I_NPOST] + (lpost * 3 + jpost) * DM;
#pragma unroll
            for (int i = 0; i < 4; ++i) Av[i] = wpost * (*(const f32x4*)(gate + lane * 4 + i * 256)) * (*(const f32x4*)(gp + lane * 4 + i * 256)); }
        if (!last) { const float* mq = mod + (size_t)(lpre * 24 + seq) * 9216 + jpre * 3072; const float* gp = p.in[I_NPRE] + (lpre * 3 + jpre) * DM;
#pragma unroll
            for (int i = 0; i < 4; ++i) { const int col = lane * 4 + i * 256; Bv[i] = (*(const f32x4*)(gp + col)) * (1.f + *(const f32x4*)(mq + 1024 + col)); Cv[i] = *(const f32x4*)(mq + col); } }
        for (int rp = 0; rp < nrow; rp += 2) {
            const int nr = nrow - rp >= 2 ? 2 : 1;
            f32x4 xv[2][4], yv[2][4];
#pragma unroll
            for (int r = 0; r < 2; ++r) { if (r < nr) { const int row = rbase + rp + r;
                if (first) { const float* xin = row < TP ? p.in[I_XP] + (size_t)row * DM : p.in[I_XS] + (size_t)(row - TP) * DM;
#pragma unroll
                    for (int i = 0; i < 4; ++i) xv[r][i] = *(const f32x4*)(xin + lane * 4 + i * 256);
                } else {
#pragma unroll
                    for (int i = 0; i < 4; ++i) { const u32x2 w = *(const u32x2*)(xrd + (size_t)row * DM + lane * 4 + i * 256);
                        xv[r][i] = (f32x4){__uint_as_float(w.x << 16), __uint_as_float(w.x & 0xffff0000u), __uint_as_float(w.y << 16), __uint_as_float(w.y & 0xffff0000u)}; }
                    if (row < TP) {
#pragma unroll
                        for (int i = 0; i < 4; ++i) { const u32x2 w = *(const u32x2*)(Y + (size_t)row * DM + lane * 4 + i * 256);
                            yv[r][i] = (f32x4){__uint_as_float(w.x << 16), __uint_as_float(w.x & 0xffff0000u), __uint_as_float(w.y << 16), __uint_as_float(w.y & 0xffff0000u)}; }
                    } else {
                        const float* ys = (const float*)(p.ws + W_YS) + (size_t)(row - TP) * DM + lane * 4;
#pragma unroll
                        for (int i = 0; i < 4; ++i) yv[r][i] = *(const f32x4*)(ys + i * 256);
                        for (int s = 1; s < nslab; ++s) {
#pragma unroll
                            for (int i = 0; i < 4; ++i) yv[r][i] += *(const f32x4*)(ys + (size_t)s * TS * DM + i * 256); }
                    } } } }
#pragma unroll
            for (int r = 0; r < 2; ++r) { if (r < nr) { const int row = rbase + rp + r;
                if (!first) {
                    float ssq = 0.f;
#pragma unroll
                    for (int i = 0; i < 4; ++i) ssq += yv[r][i][0] * yv[r][i][0] + yv[r][i][1] * yv[r][i][1] + yv[r][i][2] * yv[r][i][2] + yv[r][i][3] * yv[r][i][3];
                    ssq = wave_sum(ssq);
                    const float ry = rsqrtf(ssq * (1.f / DM) + EPS);
#pragma unroll
                    for (int i = 0; i < 4; ++i) xv[r][i] += Av[i] * (yv[r][i] * ry);
                }
                if (last) {
#pragma unroll
                    for (int i = 0; i < 4; ++i) *(f32x4*)(p.out + O_Y + (size_t)row * DM + lane * 4 + i * 256) = xv[r][i];
                } else {
#pragma unroll
                    for (int i = 0; i < 4; ++i) { u32x2 w; w.x = cvt_pk_bf16(xv[r][i][0], xv[r][i][1]); w.y = cvt_pk_bf16(xv[r][i][2], xv[r][i][3]); *(u32x2*)(xws + (size_t)row * DM + lane * 4 + i * 256) = w; }
                    float ssq = 0.f;
#pragma unroll
                    for (int i = 0; i < 4; ++i) ssq += xv[r][i][0] * xv[r][i][0] + xv[r][i][1] * xv[r][i][1] + xv[r][i][2] * xv[r][i][2] + xv[r][i][3] * xv[r][i][3];
                    ssq = wave_sum(ssq);
                    const float rx = rsqrtf(ssq * (1.f / DM) + EPS);
#pragma unroll
                    for (int i = 0; i < 4; ++i) { const f32x4 hv = (xv[r][i] * rx) * Bv[i] + Cv[i];
                        u32x2 w; w.x = cvt_pk_bf16(hv[0], hv[1]); w.y = cvt_pk_bf16(hv[2], hv[3]);
                        *(u32x2*)(H + (size_t)row * DM + lane * 4 + i * 256) = w; }
                }
            } }
        }
        }
    }
}

__device__ __forceinline__ void attn_prompt_item(const Params& p, int l, int item, LAS unsigned char* lds) {
    const int tid = fresh_tid(), wave = tid >> 6, lane = tid & 63, g = lane >> 4, li = lane & 15;
    const int b = item >> 5, h = (item >> 2) & 7, pr = item & 3;
    constexpr int STG = 128 * 72 + 64 * 136;
    LAS bf16_t* KV = (LAS bf16_t*)lds;
    LAS float* Fs = (LAS float*)(lds + 2 * STG * 2); LAS float* wtot = Fs + 2048;
    const float* proj = (const float*)(p.ws + W_PROJ);
    const bf16_t* qbuf = (const bf16_t*)(p.ws + W_QB); const bf16_t* kbuf = (const bf16_t*)(p.ws + W_KB); const bf16_t* vbuf = (const bf16_t*)(p.ws + W_VB);
    bf16_t* mixed = (bf16_t*)(p.ws + W_MIX);
    const float LOG2E = 1.4426950408889634f;
    __syncthreads();
    {
        const float fb = p.in[I_FBIAS][l * 8 + h]; float v[4];
#pragma unroll
        for (int i = 0; i < 4; ++i) v[i] = logsigmoid_f(proj[(size_t)(b * 2048 + tid * 4 + i) * NIN + 3072 + h] + fb);
        v[1] += v[0]; v[2] += v[1]; v[3] += v[2];
        float inc = v[3];
#pragma unroll
        for (int o = 1; o < 64; o <<= 1) { const float n = __shfl_up(inc, o); if (lane >= o) inc += n; }
        if (lane == 63) wtot[wave] = inc;
        __syncthreads();
        float woff = 0.f; for (int w2 = 0; w2 < wave; ++w2) woff += wtot[w2];
        const float ex = inc - v[3] + woff;
#pragma unroll
        for (int i = 0; i < 4; ++i) Fs[tid * 4 + i] = -(v[i] + ex) * LOG2E;
        __syncthreads();
    }
    const int ldkey = tid >> 3, lddseg = (tid & 7) * 8;
    for (int half = 0; half < 2; ++half) {
        const int qt = half == 0 ? (7 - pr) : pr;
        const int q0 = qt * 256 + wave * 32;
        bf16x8 qf[2][2];
#pragma unroll
        for (int qb = 0; qb < 2; ++qb)
#pragma unroll
            for (int ks = 0; ks < 2; ++ks) qf[qb][ks] = *(const bf16x8*)(qbuf + (size_t)(b * 2048 + q0 + qb * 16 + li) * 512 + h * 64 + ks * 32 + g * 8);
        float mrun[2] = {-1e30f, -1e30f}, lsum[2] = {0.f, 0.f};
        f32x4 ot[2][4];
#pragma unroll
        for (int qb = 0; qb < 2; ++qb)
#pragma unroll
            for (int db = 0; db < 4; ++db) ot[qb][db] = (f32x4){0.f, 0.f, 0.f, 0.f};
        const int nks = (qt + 1) * 2;
        const size_t ro0 = (size_t)(b * 2048 + ldkey) * 512 + h * 64 + lddseg;
        u32x4 kv0 = *(const u32x4*)(kbuf + ro0), kv1 = *(const u32x4*)(kbuf + ro0 + 64 * 512), vv0 = *(const u32x4*)(vbuf + ro0), vv1 = *(const u32x4*)(vbuf + ro0 + 64 * 512);
#define ATP_STORE(Kn, Vn) do { *(LAS u32x4*)((Kn) + ldkey * 72 + lddseg) = kv0; *(LAS u32x4*)((Kn) + (ldkey + 64) * 72 + lddseg) = kv1; \
            _Pragma("unroll") for (int i = 0; i < 4; ++i) { (Vn)[(lddseg + 2 * i) * 136 + ldkey] = (bf16_t)(vv0[i] & 0xffffu); (Vn)[(lddseg + 2 * i + 1) * 136 + ldkey] = (bf16_t)(vv0[i] >> 16); \
                (Vn)[(lddseg + 2 * i) * 136 + 64 + ldkey] = (bf16_t)(vv1[i] & 0xffffu); (Vn)[(lddseg + 2 * i + 1) * 136 + 64 + ldkey] = (bf16_t)(vv1[i] >> 16); } } while (0)
        __syncthreads();
        ATP_STORE(KV, KV + 128 * 72);
        __syncthreads();
        for (int ks = 0; ks < nks; ++ks) {
            LAS bf16_t* Kst = KV + (ks & 1) * STG; LAS bf16_t* Vst = Kst + 128 * 72;
            if (ks + 1 < nks) { const size_t ro = ro0 + (size_t)((ks + 1) * 128) * 512; kv0 = *(const u32x4*)(kbuf + ro); kv1 = *(const u32x4*)(kbuf + ro + 64 * 512); vv0 = *(const u32x4*)(vbuf + ro); vv1 = *(const u32x4*)(vbuf + ro + 64 * 512); }
#pragma unroll
            for (int sub = 0; sub < 2; ++sub) {
            const int k0 = ks * 128 + sub * 64;
            LAS bf16_t* Ks = Kst + sub * 64 * 72; LAS bf16_t* Vt = Vst + sub * 64;
            if (k0 <= q0 + 31) {
                f32x4 st[2][4];
#pragma unroll
                for (int kb = 0; kb < 4; ++kb) {
                    const bf16x8 kf0 = *(const LAS bf16x8*)(Ks + (kb * 16 + li) * 72 + g * 8), kf1 = *(const LAS bf16x8*)(Ks + (kb * 16 + li) * 72 + 32 + g * 8);
#pragma unroll
                    for (int qb = 0; qb < 2; ++qb) { f32x4 z = (f32x4){0.f, 0.f, 0.f, 0.f};
                        z = __builtin_amdgcn_mfma_f32_16x16x32_bf16(kf0, qf[qb][0], z, 0, 0, 0);
                        st[qb][kb] = __builtin_amdgcn_mfma_f32_16x16x32_bf16(kf1, qf[qb][1], z, 0, 0, 0); }
                }
                const bool need_mask = (k0 + 63 > q0);
#pragma unroll
                for (int qb = 0; qb < 2; ++qb) {
                    const int qg = q0 + qb * 16 + li;
                    float mx = -1e30f;
                    if (need_mask) {
#pragma unroll
                        for (int kb = 0; kb < 4; ++kb) { const f32x4 fk = *(const LAS f32x4*)(Fs + k0 + kb * 16 + g * 4);
#pragma unroll
                            for (int j = 0; j < 4; ++j) { float s = st[qb][kb][j] * (0.125f * LOG2E) + fk[j]; const int kg = k0 + kb * 16 + g * 4 + j;
                                if (kg > qg) s = -1e30f; st[qb][kb][j] = s; mx = fmaxf(mx, s); } }
                    } else {
#pragma unroll
                        for (int kb = 0; kb < 4; ++kb) { const f32x4 fk = *(const LAS f32x4*)(Fs + k0 + kb * 16 + g * 4);
#pragma unroll
                            for (int j = 0; j < 4; ++j) { const float s = st[qb][kb][j] * (0.125f * LOG2E) + fk[j]; st[qb][kb][j] = s; mx = fmaxf(mx, s); } }
                    }
                    mx = fmaxf(mx, __shfl_xor(mx, 16)); mx = fmaxf(mx, __shfl_xor(mx, 32));
                    const float mn = fmaxf(mrun[qb], mx); const float alpha = __builtin_amdgcn_exp2f(mrun[qb] - mn); mrun[qb] = mn;
                    float ps = 0.f;
#pragma unroll
                    for (int kb = 0; kb < 4; ++kb)
#pragma unroll
                        for (int j = 0; j < 4; ++j) { const float pv = __builtin_amdgcn_exp2f(st[qb][kb][j] - mn); st[qb][kb][j] = pv; ps += pv; }
                    lsum[qb] = lsum[qb] * alpha + ps;
#pragma unroll
                    for (int db = 0; db < 4; ++db) ot[qb][db] *= alpha;
                }
#pragma unroll
                for (int kstep = 0; kstep < 2; ++kstep) {
                    bf16x8 pf[2];
#pragma unroll
                    for (int qb = 0; qb < 2; ++qb) { u32x4 w; w.x = cvt_pk_bf16(st[qb][2 * kstep][0], st[qb][2 * kstep][1]); w.y = cvt_pk_bf16(st[qb][2 * kstep][2], st[qb][2 * kstep][3]);
                        w.z = cvt_pk_bf16(st[qb][2 * kstep + 1][0], st[qb][2 * kstep + 1][1]); w.w = cvt_pk_bf16(st[qb][2 * kstep + 1][2], st[qb][2 * kstep + 1][3]); pf[qb] = __builtin_bit_cast(bf16x8, w); }
#pragma unroll
                    for (int db = 0; db < 4; ++db) {
                        const u32x2 va = *(const LAS u32x2*)(Vt + (db * 16 + li) * 136 + kstep * 32 + g * 4), vb2 = *(const LAS u32x2*)(Vt + (db * 16 + li) * 136 + kstep * 32 + 16 + g * 4);
                        const u32x4 vc = {va.x, va.y, vb2.x, vb2.y}; const bf16x8 vf = __builtin_bit_cast(bf16x8, vc);
#pragma unroll
                        for (int qb = 0; qb < 2; ++qb) ot[qb][db] = __builtin_amdgcn_mfma_f32_16x16x32_bf16(vf, pf[qb], ot[qb][db], 0, 0, 0);
                    }
                }
            }
            }
            if (ks + 1 < nks) { LAS bf16_t* Kn = KV + ((ks + 1) & 1) * STG; ATP_STORE(Kn, Kn + 128 * 72); }
            __syncthreads();
        }
#undef ATP_STORE
#pragma unroll
        for (int qb = 0; qb < 2; ++qb) {
            float lt = lsum[qb]; lt += __shfl_xor(lt, 16); lt += __shfl_xor(lt, 32);
            const float inv = 1.f / lt; const size_t row = (size_t)(b * 2048 + q0 + qb * 16 + li);
#pragma unroll
            for (int db = 0; db < 4; ++db) { const f32x4 o = ot[qb][db] * inv; u32x2 w; w.x = cvt_pk_bf16(o[0], o[1]); w.y = cvt_pk_bf16(o[2], o[3]);
                *(u32x2*)(mixed + row * DM + 256 + h * 64 + db * 16 + g * 4) = w; }
        }
    }
    __syncthreads();
}

__device__ __forceinline__ void attn_sample_block(const Params& p, int l, int bid, int nb, LAS unsigned char* lds) {
    const int tid = fresh_tid(), wave = tid >> 6, lane = tid & 63, g = lane >> 4, li = lane & 15;
    LAS bf16_t* Vt = (LAS bf16_t*)lds + wave * (64 * 40);
    LAS float* cmb = (LAS float*)(lds + 8 * 64 * 40 * 2);
    const float* proj = (const float*)(p.ws + W_PROJ); const bf16_t* qbuf = (const bf16_t*)(p.ws + W_QB);
    const float LOG2E = 1.4426950408889634f;
    f32x4 kr[8], vr[8]; float fkr[8];
#define ATS_ISSUE(item_, step_) do { const int _bh = (item_) >> 1, _sp = (item_) & 1, _b = _bh >> 3, _h = _bh & 7; const bool _new = (step_) == 8; \
        const int _key0 = _sp * 2048 + wave * 256 + (step_) * 32; \
        const float* _kp = _new ? p.out + O_SK + (size_t)((l * 16 + _b) * 32) * 512 + _h * 64 : p.in[I_CK] + ((size_t)(l * 16 + _b) * 4096 + _key0) * 512 + _h * 64; \
        const float* _vp = _new ? p.out + O_SV + (size_t)((l * 16 + _b) * 32) * 512 + _h * 64 : p.in[I_CV] + ((size_t)(l * 16 + _b) * 4096 + _key0) * 512 + _h * 64; \
        _Pragma("unroll") for (int kb = 0; kb < 2; ++kb) _Pragma("unroll") for (int ks = 0; ks < 2; ++ks) { const float* a = _kp + (size_t)(kb * 16 + li) * 512 + ks * 32 + g * 8; kr[(kb * 2 + ks) * 2] = *(const f32x4*)a; kr[(kb * 2 + ks) * 2 + 1] = *(const f32x4*)(a + 4); } \
        _Pragma("unroll") for (int i = 0; i < 8; ++i) vr[i] = *(const f32x4*)(_vp + (size_t)(i * 4 + g) * 512 + li * 4); \
        if (!_new) { const float* _fc = (const float*)(p.ws + W_FC) + ((size_t)(l * 16 + _b) * 4096 + _key0) * 8 + _h; \
            _Pragma("unroll") for (int kb = 0; kb < 2; ++kb) _Pragma("unroll") for (int j = 0; j < 4; ++j) fkr[kb * 4 + j] = _fc[(size_t)(kb * 16 + g * 4 + j) * 8]; } \
    } while (0)
    int it = bid;
    if (it < 256) ATS_ISSUE(it, 0);
    __syncthreads();
    for (; it < 256; it += nb) {
        const int bh = it >> 1, sp = it & 1, b = bh >> 3, h = bh & 7;
        const int nst = 8 + ((sp == 1 && wave == 0) ? 1 : 0);
        const float* Fc = (const float*)(p.ws + W_FC) + (size_t)(l * 16 + b) * 4096 * 8 + h;
        float cst = lane < 32 ? logsigmoid_f(proj[(size_t)(TP + b * 32 + lane) * NIN + 3072 + h] + p.in[I_FBIAS][l * 8 + h]) : 0.f;
#pragma unroll
        for (int o = 1; o < 32; o <<= 1) { const float n = __shfl_up(cst, o); if (lane >= o) cst += n; }
        const float FcLast = Fc[4095 * 8];
        float Fq[2]; Fq[0] = (FcLast + __shfl(cst, li)) * LOG2E; Fq[1] = (FcLast + __shfl(cst, 16 + li)) * LOG2E;
        bf16x8 qf[2][2];
#pragma unroll
        for (int qb = 0; qb < 2; ++qb)
#pragma unroll
            for (int ks = 0; ks < 2; ++ks) qf[qb][ks] = *(const bf16x8*)(qbuf + (size_t)(TP + b * 32 + qb * 16 + li) * 512 + h * 64 + ks * 32 + g * 8);
        float mrun[2] = {-1e30f, -1e30f}, lsum[2] = {0.f, 0.f};
        f32x4 ot[2][4];
#pragma unroll
        for (int qb = 0; qb < 2; ++qb)
#pragma unroll
            for (int db = 0; db < 4; ++db) ot[qb][db] = (f32x4){0.f, 0.f, 0.f, 0.f};
        for (int step = 0; step < nst; ++step) {
            const bool isnew = step == 8;
            bf16x8 kf[2][2]; float fk[2][4];
#pragma unroll
            for (int kb = 0; kb < 2; ++kb)
#pragma unroll
                for (int ks = 0; ks < 2; ++ks) { const f32x4 x0 = kr[(kb * 2 + ks) * 2], x1 = kr[(kb * 2 + ks) * 2 + 1];
                    u32x4 w; w.x = cvt_pk_bf16(x0[0], x0[1]); w.y = cvt_pk_bf16(x0[2], x0[3]); w.z = cvt_pk_bf16(x1[0], x1[1]); w.w = cvt_pk_bf16(x1[2], x1[3]); kf[kb][ks] = __builtin_bit_cast(bf16x8, w); }
#pragma unroll
            for (int i = 0; i < 8; ++i) { const int key = i * 4 + g;
#pragma unroll
                for (int c = 0; c < 4; ++c) Vt[(li * 4 + c) * 40 + key] = f2bf(vr[i][c]); }
#pragma unroll
            for (int kb = 0; kb < 2; ++kb)
#pragma unroll
                for (int j = 0; j < 4; ++j) { const int kk = kb * 16 + g * 4 + j; const float cn = __shfl(cst, kk); fk[kb][j] = (isnew ? FcLast + cn : fkr[kb * 4 + j]) * LOG2E; }
            asm volatile("s_waitcnt lgkmcnt(0)" ::: "memory");
            if (step + 1 < nst) ATS_ISSUE(it, step + 1);
            else if (it + nb < 256) ATS_ISSUE(it + nb, 0);
            f32x4 st[2][2];
#pragma unroll
            for (int kb = 0; kb < 2; ++kb)
#pragma unroll
                for (int qb = 0; qb < 2; ++qb) { f32x4 z = (f32x4){0.f, 0.f, 0.f, 0.f};
                    z = __builtin_amdgcn_mfma_f32_16x16x32_bf16(kf[kb][0], qf[qb][0], z, 0, 0, 0);
                    st[qb][kb] = __builtin_amdgcn_mfma_f32_16x16x32_bf16(kf[kb][1], qf[qb][1], z, 0, 0, 0); }
#pragma unroll
            for (int qb = 0; qb < 2; ++qb) {
                const int qq = qb * 16 + li;
                float mx = -1e30f;
#pragma unroll
                for (int kb = 0; kb < 2; ++kb)
#pragma unroll
                    for (int j = 0; j < 4; ++j) { float s = st[qb][kb][j] * (0.125f * LOG2E) + (Fq[qb] - fk[kb][j]); const int kk = kb * 16 + g * 4 + j;
                        if (isnew && kk > qq) s = -1e30f; st[qb][kb][j] = s; mx = fmaxf(mx, s); }
                mx = fmaxf(mx, __shfl_xor(mx, 16)); mx = fmaxf(mx, __shfl_xor(mx, 32));
                const float mn = fmaxf(mrun[qb], mx); const float alpha = __builtin_amdgcn_exp2f(mrun[qb] - mn); mrun[qb] = mn;
                float ps = 0.f;
#pragma unroll
                for (int kb = 0; kb < 2; ++kb)
#pragma unroll
                    for (int j = 0; j < 4; ++j) { const float pv = __builtin_amdgcn_exp2f(st[qb][kb][j] - mn); st[qb][kb][j] = pv; ps += pv; }
                lsum[qb] = lsum[qb] * alpha + ps;
#pragma unroll
                for (int db = 0; db < 4; ++db) ot[qb][db] *= alpha;
            }
            bf16x8 pf[2];
#pragma unroll
            for (int qb = 0; qb < 2; ++qb) { u32x4 w; w.x = cvt_pk_bf16(st[qb][0][0], st[qb][0][1]); w.y = cvt_pk_bf16(st[qb][0][2], st[qb][0][3]);
                w.z = cvt_pk_bf16(st[qb][1][0], st[qb][1][1]); w.w = cvt_pk_bf16(st[qb][1][2], st[qb][1][3]); pf[qb] = __builtin_bit_cast(bf16x8, w); }
#pragma unroll
            for (int db = 0; db < 4; ++db) {
                const u32x2 va = *(const LAS u32x2*)(Vt + (db * 16 + li) * 40 + g * 4), vb2 = *(const LAS u32x2*)(Vt + (db * 16 + li) * 40 + 16 + g * 4);
                const u32x4 vc = {va.x, va.y, vb2.x, vb2.y}; const bf16x8 vf = __builtin_bit_cast(bf16x8, vc);
#pragma unroll
                for (int qb = 0; qb < 2; ++qb) ot[qb][db] = __builtin_amdgcn_mfma_f32_16x16x32_bf16(vf, pf[qb], ot[qb][db], 0, 0, 0);
            }
            asm volatile("s_waitcnt lgkmcnt(0)" ::: "memory");
        }
#pragma unroll
        for (int qb = 0; qb < 2; ++qb) {
            float lt = lsum[qb]; lt += __shfl_xor(lt, 16); lt += __shfl_xor(lt, 32);
            LAS float* rowp = cmb + (wave * 32 + qb * 16 + li) * 66;
#pragma unroll
            for (int db = 0; db < 4; ++db)
#pragma unroll
                for (int j = 0; j < 4; ++j) rowp[db * 16 + g * 4 + j] = ot[qb][db][j];
            if (g == 0) { rowp[64] = mrun[qb]; rowp[65] = lt; }
        }
        __syncthreads();
        {
            const int q = tid >> 4, dq = (tid & 15) * 4;
            float M = -1e30f;
#pragma unroll
            for (int w = 0; w < 8; ++w) M = fmaxf(M, cmb[(w * 32 + q) * 66 + 64]);
            float Lt = 0.f; f32x4 O = (f32x4){0.f, 0.f, 0.f, 0.f};
#pragma unroll
            for (int w = 0; w < 8; ++w) { LAS const float* rp = cmb + (w * 32 + q) * 66; const float e = __builtin_amdgcn_exp2f(rp[64] - M); Lt += rp[65] * e;
                O[0] += rp[dq] * e; O[1] += rp[dq + 1] * e; O[2] += rp[dq + 2] * e; O[3] += rp[dq + 3] * e; }
            *(f32x4*)((float*)(p.ws + W_PO) + ((size_t)it * 32 + q) * 64 + dq) = O;
            if ((tid & 15) == 0) { ((float*)(p.ws + W_PM))[it * 32 + q] = M; ((float*)(p.ws + W_PL))[it * 32 + q] = Lt; }
        }
        __syncthreads();
    }
#undef ATS_ISSUE
}

__device__ __forceinline__ void attn_sample_combine(const Params& p, int bh) {
    const int tid = fresh_tid(), q = tid >> 4, dq = (tid & 15) * 4, b = bh >> 3, h = bh & 7;
    const float* PO = (const float*)(p.ws + W_PO); const float* PM = (const float*)(p.ws + W_PM); const float* PL = (const float*)(p.ws + W_PL);
    float M = -1e30f;
#pragma unroll
    for (int s = 0; s < 2; ++s) M = fmaxf(M, PM[(bh * 2 + s) * 32 + q]);
    float Lt = 0.f; f32x4 O = (f32x4){0.f, 0.f, 0.f, 0.f};
#pragma unroll
    for (int s = 0; s < 2; ++s) { const float e = __builtin_amdgcn_exp2f(PM[(bh * 2 + s) * 32 + q] - M); Lt += PL[(bh * 2 + s) * 32 + q] * e; O += *(const f32x4*)(PO + ((size_t)(bh * 2 + s) * 32 + q) * 64 + dq) * e; }
    const float inv = 1.f / Lt; O *= inv;
    u32x2 w; w.x = cvt_pk_bf16(O[0], O[1]); w.y = cvt_pk_bf16(O[2], O[3]);
    *(u32x2*)((bf16_t*)(p.ws + W_MIX) + (size_t)(TP + b * 32 + q) * DM + 256 + h * 64 + dq) = w;
}

__device__ __forceinline__ void lru_local_item(const Params& p, int l, int ci, LAS unsigned char* lds) {
    const int tid = fresh_tid(), wave = tid >> 6, lane = tid & 63, g = lane >> 4, li = lane & 15; const CItem it = citem(ci); const int L = it.L, row0 = it.row0;
    LAS float* xs = (LAS float*)lds; LAS float* us = xs + 67 * 256;
    const float* proj = (const float*)(p.ws + W_PROJ);
    const int hd = wave >> 1, jh = wave & 1;
    __syncthreads();
    for (int i = tid; i < (L + 3) * 64; i += 512) { const int r = i >> 6, c4 = (i & 63) * 4, t = r - 3; f32x4 v;
        if (t >= 0 || (it.prompt && it.c > 0)) v = *(const f32x4*)(proj + (size_t)(row0 + t) * NIN + c4);
        else if (it.prompt) v = (f32x4){0.f, 0.f, 0.f, 0.f};
        else v = *(const f32x4*)(p.in[I_SLCONV] + ((l * 16 + it.b) * 3 + r) * 256 + c4);
        *(LAS f32x4*)(xs + r * 256 + c4) = v; }
    bf16x8 Wf[2][2][2];
#pragma unroll
    for (int gate = 0; gate < 2; ++gate)
#pragma unroll
        for (int jb = 0; jb < 2; ++jb)
#pragma unroll
            for (int ks = 0; ks < 2; ++ks) { const float* wp = (gate ? p.in[I_LWX] : p.in[I_LWA]) + (size_t)((l * 4 + hd) * 64 + ks * 32 + g * 8) * 64 + jh * 32 + jb * 16 + li;
                float w[8];
#pragma unroll
                for (int e = 0; e < 8; ++e) w[e] = wp[e * 64];
                u32x4 pk; pk.x = cvt_pk_bf16(w[0], w[1]); pk.y = cvt_pk_bf16(w[2], w[3]); pk.z = cvt_pk_bf16(w[4], w[5]); pk.w = cvt_pk_bf16(w[6], w[7]); Wf[gate][jb][ks] = __builtin_bit_cast(bf16x8, pk); }
    __syncthreads();
    {   const int ch = tid & 255, tb0 = (tid >> 8) * 32;
        if (tb0 < L) {
            const float w0 = p.in[I_LCW][(l * 4 + 0) * 256 + ch], w1 = p.in[I_LCW][(l * 4 + 1) * 256 + ch], w2 = p.in[I_LCW][(l * 4 + 2) * 256 + ch], w3 = p.in[I_LCW][(l * 4 + 3) * 256 + ch], bb = p.in[I_LCB][l * 256 + ch];
            for (int t = tb0; t < tb0 + 32; ++t) us[t * 260 + ch] = bb + w0 * xs[t * 256 + ch] + w1 * xs[(t + 1) * 256 + ch] + w2 * xs[(t + 2) * 256 + ch] + w3 * xs[(t + 3) * 256 + ch];
        } }
    __syncthreads();
    float bav[2], bxv[2], spl[2]; float Pc[2] = {1.f, 1.f}, Hc[2] = {0.f, 0.f};
#pragma unroll
    for (int jb = 0; jb < 2; ++jb) { const int ch = hd * 64 + jh * 32 + jb * 16 + li; bav[jb] = p.in[I_LBA][l * 256 + ch]; bxv[jb] = p.in[I_LBX][l * 256 + ch]; spl[jb] = softplus_f(-p.in[I_LLAM][l * 256 + ch]); }
    float* acum = (float*)(p.ws + W_ACUM); float* hloc = (float*)(p.ws + W_HLOC);
    for (int tb = 0; tb * 16 < L; ++tb) {
        bf16x8 Uf[2];
#pragma unroll
        for (int ks = 0; ks < 2; ++ks) { LAS const float* up = us + (tb * 16 + li) * 260 + hd * 64 + ks * 32 + g * 8; const f32x4 x0 = *(const LAS f32x4*)up, x1 = *(const LAS f32x4*)(up + 4);
            u32x4 pk; pk.x = cvt_pk_bf16(x0[0], x0[1]); pk.y = cvt_pk_bf16(x0[2], x0[3]); pk.z = cvt_pk_bf16(x1[0], x1[1]); pk.w = cvt_pk_bf16(x1[2], x1[3]); Uf[ks] = __builtin_bit_cast(bf16x8, pk); }
#pragma unroll
        for (int jb = 0; jb < 2; ++jb) {
            f32x4 ga = (f32x4){0.f, 0.f, 0.f, 0.f}, gx = (f32x4){0.f, 0.f, 0.f, 0.f};
#pragma unroll
            for (int ks = 0; ks < 2; ++ks) { ga = __builtin_amdgcn_mfma_f32_16x16x32_bf16(Uf[ks], Wf[0][jb][ks], ga, 0, 0, 0); gx = __builtin_amdgcn_mfma_f32_16x16x32_bf16(Uf[ks], Wf[1][jb][ks], gx, 0, 0, 0); }
            const int ch = hd * 64 + jh * 32 + jb * 16 + li;
            float Pl[4], Hl[4];
#pragma unroll
            for (int jj = 0; jj < 4; ++jj) { const int t = tb * 16 + g * 4 + jj;
                const float r = sigmoid_f(ga[jj] + bav[jb]), ig = sigmoid_f(gx[jj] + bxv[jb]); const float la = -8.f * r * spl[jb]; const float a = __expf(la);
                const float bc = sqrtf(fmaxf(1.f - a * a, 0.f)) * (ig * us[t * 260 + ch]);
                if (jj == 0) { Pl[0] = a; Hl[0] = bc; } else { Pl[jj] = Pl[jj - 1] * a; Hl[jj] = a * Hl[jj - 1] + bc; } }
            float EP = 1.f, EH = 0.f;
#pragma unroll
            for (int gg = 0; gg < 3; ++gg) { const float Pg = __shfl(Pl[3], li + 16 * gg), Hg = __shfl(Hl[3], li + 16 * gg); if (gg < g) { EH = Pg * EH + Hg; EP *= Pg; } }
            const float Pin = Pc[jb] * EP, Hin = EP * Hc[jb] + EH;
#pragma unroll
            for (int jj = 0; jj < 4; ++jj) { const size_t o = (size_t)(row0 + tb * 16 + g * 4 + jj) * 256 + ch; acum[o] = Pin * Pl[jj]; hloc[o] = Pl[jj] * Hin + Hl[jj]; }
            const float Pe = Pin * Pl[3], He = Pl[3] * Hin + Hl[3];
            Pc[jb] = __shfl(Pe, li + 48); Hc[jb] = __shfl(He, li + 48);
        }
    }
    if (g == 0) {
#pragma unroll
        for (int jb = 0; jb < 2; ++jb) { const int ch = hd * 64 + jh * 32 + jb * 16 + li; ((float*)(p.ws + W_AGGA))[ci * 256 + ch] = Pc[jb]; ((float*)(p.ws + W_AGGB))[ci * 256 + ch] = Hc[jb]; } }
    __syncthreads();
}

__device__ __forceinline__ void lru_final_item(const Params& p, int l, int ci) {
    const int tid = fresh_tid(); const CItem it = citem(ci); const int L = it.L, row0 = it.row0;
    const int ch = tid & 255, th = tid >> 8, tb = th * 32;
    const float* proj = (const float*)(p.ws + W_PROJ); const float* aggA = (const float*)(p.ws + W_AGGA); const float* aggB = (const float*)(p.ws + W_AGGB);
    const float* acum = (const float*)(p.ws + W_ACUM); const float* hloc = (const float*)(p.ws + W_HLOC); bf16_t* mixed = (bf16_t*)(p.ws + W_MIX);
    float hin = it.prompt ? 0.f : p.in[I_SLH][(l * 16 + it.b) * 256 + ch];
    for (int c2 = 0; c2 < it.c; c2 += 8) { float aa[8], ab[8];
#pragma unroll
        for (int k = 0; k < 8; ++k) { const int cc = min(c2 + k, it.c - 1); aa[k] = aggA[(ci - it.c + cc) * 256 + ch]; ab[k] = aggB[(ci - it.c + cc) * 256 + ch]; }
#pragma unroll
        for (int k = 0; k < 8; ++k) if (c2 + k < it.c) hin = aa[k] * hin + ab[k]; }
    if (tb < L) {
        for (int t0 = 0; t0 < 32; t0 += 16) {
            float av[16], hl[16], gv[16];
#pragma unroll
            for (int k = 0; k < 16; ++k) { const size_t row = (size_t)(row0 + tb + t0 + k); av[k] = acum[row * 256 + ch]; hl[k] = hloc[row * 256 + ch]; gv[k] = proj[row * NIN + 256 + ch]; }
#pragma unroll
            for (int k = 0; k < 16; ++k) { const size_t row = (size_t)(row0 + tb + t0 + k); const float hv = av[k] * hin + hl[k];
                mixed[row * DM + ch] = f2bf(hv * gelu_tanh_f(gv[k]));
                if (it.lastc && tb + t0 + k == L - 1) p.out[(it.prompt ? O_PLH + (size_t)(l * 8 + it.b) * 256 : O_SLH + (size_t)(l * 16 + it.b) * 256) + ch] = hv; }
        }
    }
    if (it.lastc) for (int i = tid; i < 3 * 256; i += 512) { const int r = i >> 8, c2 = i & 255;
        p.out[(it.prompt ? O_PLCONV + (size_t)((l * 8 + it.b) * 3 + r) * 256 : O_SLCONV + (size_t)((l * 16 + it.b) * 3 + r) * 256) + c2] = proj[(size_t)(row0 + L - 3 + r) * NIN + c2]; }
}

__device__ __forceinline__ void ssd1_item(const Params& p, int l, int ci, LAS unsigned char* lds) {
    const int tid = fresh_tid(), wave = tid >> 6, lane = tid & 63, g = lane >> 4, li = lane & 15; const CItem it = citem(ci); const int L = it.L, row0 = it.row0;
    LAS bf16_t* xdT = (LAS bf16_t*)lds; LAS bf16_t* BT = xdT + 256 * 72;
    LAS float* dts = (LAS float*)(lds + 2 * 256 * 72 * 2); LAS float* cums = dts + 256;
    const float* proj = (const float*)(p.ws + W_PROJ); float* xact = (float*)(p.ws + W_XACT);
    __syncthreads();
    if (tid < L * 4) { const int t = tid >> 2, hh = tid & 3; const float dtv = softplus_f(proj[(size_t)(row0 + t) * NIN + 3080 + hh] + p.in[I_SDTB][l * 4 + hh]);
        dts[tid] = dtv; ((float*)(p.ws + W_DTB))[(size_t)row0 * 4 + tid] = dtv; }
    for (int i = tid; i < L * 8; i += 512) { const int t = i >> 3, hh = i & 7; const float v = logsigmoid_f(proj[(size_t)(row0 + t) * NIN + 3072 + hh] + p.in[I_FBIAS][l * 8 + hh]);
        const int row = row0 + t; p.out[(row < TP ? O_PLOGF + ((size_t)l * TP + row) * 8 : O_SLOGF + ((size_t)l * TS + (row - TP)) * 8) + hh] = v; }
    if (it.lastc) for (int i = tid; i < 3 * 768; i += 512) { const int r = i / 768, c2 = i % 768;
        p.out[(it.prompt ? O_PSCONV + (size_t)((l * 8 + it.b) * 3 + r) * 768 : O_SSCONV + (size_t)((l * 16 + it.b) * 3 + r) * 768) + c2] = proj[(size_t)(row0 + L - 3 + r) * NIN + 2304 + c2]; }
    __syncthreads();
    if (tid < 256) { const int hh = tid >> 6, t = tid & 63; const float A = -expf(p.in[I_SALOG][l * 4 + hh]);
        float v = t < L ? dts[t * 4 + hh] * A : 0.f;
#pragma unroll
        for (int o = 1; o < 64; o <<= 1) { const float n = __shfl_up(v, o); if (t >= o) v += n; }
        if (t < L) { cums[t * 4 + hh] = v; ((float*)(p.ws + W_CUMB))[(size_t)(row0 + t) * 4 + hh] = v; }
        if (t == L - 1) ((float*)(p.ws + W_CDEC))[ci * 4 + hh] = expf(v); }
    __syncthreads();
    for (int task = tid; task < (L >> 3) * 192; task += 512) {
        const int tg = task / 192, ch = (task % 192) * 4, t0 = tg * 8;
        const f32x4 w0 = *(const f32x4*)(p.in[I_SCW] + (l * 4 + 0) * 768 + ch), w1 = *(const f32x4*)(p.in[I_SCW] + (l * 4 + 1) * 768 + ch), w2 = *(const f32x4*)(p.in[I_SCW] + (l * 4 + 2) * 768 + ch),
                    w3 = *(const f32x4*)(p.in[I_SCW] + (l * 4 + 3) * 768 + ch), bb = *(const f32x4*)(p.in[I_SCB] + l * 768 + ch);
        f32x4 xr[11];
#pragma unroll
        for (int r = 0; r < 11; ++r) { const int t = t0 - 3 + r;
            if (t >= 0 || (it.prompt && it.c > 0)) xr[r] = *(const f32x4*)(proj + (size_t)(row0 + t) * NIN + 2304 + ch);
            else if (it.prompt) xr[r] = (f32x4){0.f, 0.f, 0.f, 0.f};
            else xr[r] = *(const f32x4*)(p.in[I_SSCONV] + (size_t)((l * 16 + it.b) * 3 + (t + 3)) * 768 + ch); }
        f32x4 vv[8];
#pragma unroll
        for (int i = 0; i < 8; ++i) { f32x4 v = bb + w0 * xr[i] + w1 * xr[i + 1] + w2 * xr[i + 2] + w3 * xr[i + 3];
            v[0] = silu_f(v[0]); v[1] = silu_f(v[1]); v[2] = silu_f(v[2]); v[3] = silu_f(v[3]);
            *(f32x4*)(xact + (size_t)(row0 + t0 + i) * 768 + ch) = v; vv[i] = v;
            if (ch >= 256) { u32x2 w; w.x = cvt_pk_bf16(v[0], v[1]); w.y = cvt_pk_bf16(v[2], v[3]); *(u32x2*)((bf16_t*)(p.ws + W_XB16) + (size_t)(row0 + t0 + i) * 512 + ch - 256) = w; } }
        if (ch < 512) {
            if (ch < 256) { const int hh = ch >> 6; const float cl = cums[(L - 1) * 4 + hh];
#pragma unroll
                for (int i = 0; i < 8; ++i) vv[i] *= __expf(cl - cums[(t0 + i) * 4 + hh]) * dts[(t0 + i) * 4 + hh]; }
            LAS bf16_t* dst = (ch < 256 ? xdT + ch * 72 : BT + (ch - 256) * 72) + t0;
#pragma unroll
            for (int c = 0; c < 4; ++c) { u32x4 w; w.x = cvt_pk_bf16(vv[0][c], vv[1][c]); w.y = cvt_pk_bf16(vv[2][c], vv[3][c]); w.z = cvt_pk_bf16(vv[4][c], vv[5][c]); w.w = cvt_pk_bf16(vv[6][c], vv[7][c]);
                *(LAS u32x4*)(dst + c * 72) = w; }
        }
    }
    __syncthreads();
    {   const int hh = wave >> 1, ph = wave & 1, gi = hh >> 1; float* states = (float*)(p.ws + W_STATES);
#pragma unroll
        for (int pb = 0; pb < 2; ++pb) {
            bf16x8 Af[2];
#pragma unroll
            for (int ks = 0; ks < 2; ++ks) if (ks * 32 < L) Af[ks] = *(const LAS bf16x8*)(xdT + (hh * 64 + ph * 32 + pb * 16 + li) * 72 + ks * 32 + g * 8);
#pragma unroll
            for (int n8 = 0; n8 < 8; ++n8) {
                f32x4 a = (f32x4){0.f, 0.f, 0.f, 0.f};
#pragma unroll
                for (int ks = 0; ks < 2; ++ks) if (ks * 32 < L) { const bf16x8 Bf = *(const LAS bf16x8*)(BT + (gi * 128 + n8 * 16 + li) * 72 + ks * 32 + g * 8); a = __builtin_amdgcn_mfma_f32_16x16x32_bf16(Af[ks], Bf, a, 0, 0, 0); }
#pragma unroll
                for (int jj = 0; jj < 4; ++jj) states[((size_t)(ci * 4 + hh) * 64 + ph * 32 + pb * 16 + g * 4 + jj) * 128 + n8 * 16 + li] = a[jj];
            }
        }
    }
    __syncthreads();
}

__device__ __forceinline__ void ssd_scan_item(const Params& p, int l, int idx) {
    const int tid = fresh_tid(); float* states = (float*)(p.ws + W_STATES); const float* cdec = (const float*)(p.ws + W_CDEC);
    if (idx < 128) { const int seq = idx >> 4, e0 = (idx & 15) * 2048 + tid * 4, hh = e0 >> 13;
        f32x4 run = (f32x4){0.f, 0.f, 0.f, 0.f};
        for (int c0 = 0; c0 < 32; c0 += 8) { f32x4 st[8]; float dec[8];
#pragma unroll
            for (int k = 0; k < 8; ++k) { const int ci = seq * 32 + c0 + k; dec[k] = cdec[ci * 4 + hh]; st[k] = *(const f32x4*)(states + (size_t)ci * 32768 + e0); }
#pragma unroll
            for (int k = 0; k < 8; ++k) { const int ci = seq * 32 + c0 + k; *(f32x4*)(states + (size_t)ci * 32768 + e0) = run;
                u32x2 w; w.x = cvt_pk_bf16(run[0], run[1]); w.y = cvt_pk_bf16(run[2], run[3]); *(u32x2*)((bf16_t*)(p.ws + W_HS16) + (size_t)ci * 32768 + e0) = w; run = dec[k] * run + st[k]; } }
        *(f32x4*)(p.out + O_PSH + (size_t)(l * 8 + seq) * 32768 + e0) = run;
    } else { const int b = (idx - 128) >> 4, e0 = ((idx - 128) & 15) * 2048 + tid * 4, hh = e0 >> 13, ci = 256 + b;
        const f32x4 h0 = *(const f32x4*)(p.in[I_SSH] + (size_t)(l * 16 + b) * 32768 + e0); const float dec = cdec[ci * 4 + hh]; float* sp = states + (size_t)ci * 32768 + e0; const f32x4 st = *(const f32x4*)sp;
        *(f32x4*)(p.out + O_SSH + (size_t)(l * 16 + b) * 32768 + e0) = dec * h0 + st; }
}

__device__ __forceinline__ bf16x8 frag_from_f32(const float* a) {
    const f32x4 x0 = *(const f32x4*)a, x1 = *(const f32x4*)(a + 4);
    u32x4 w; w.x = cvt_pk_bf16(x0[0], x0[1]); w.y = cvt_pk_bf16(x0[2], x0[3]); w.z = cvt_pk_bf16(x1[0], x1[1]); w.w = cvt_pk_bf16(x1[2], x1[3]);
    return __builtin_bit_cast(bf16x8, w);
}
__device__ __forceinline__ void ssd3_item(const Params& p, int l, int ci, LAS unsigned char* lds) {
    const int tid = fresh_tid(), wave = tid >> 6, lane = tid & 63, g = lane >> 4, li = lane & 15; const CItem it = citem(ci); const int L = it.L, row0 = it.row0;
    const int hh = wave >> 1, qh = wave & 1, gi = hh >> 1;
    LAS bf16_t* xT = (LAS bf16_t*)lds + wave * (64 * 72);
    LAS float* cumT = (LAS float*)(lds + 8 * 64 * 72 * 2); LAS float* dtT = cumT + 256; LAS float* ssqp = dtT + 256;
    const float* xact = (const float*)(p.ws + W_XACT); const float* proj = (const float*)(p.ws + W_PROJ);
    const bf16_t* xb16 = (const bf16_t*)(p.ws + W_XB16); const bf16_t* hs16 = (const bf16_t*)(p.ws + W_HS16) + (size_t)(it.prompt ? ci : 0) * 32768;
    const float* hst = it.prompt ? (const float*)(p.ws + W_STATES) + (size_t)ci * 32768 : p.in[I_SSH] + (size_t)(l * 16 + it.b) * 32768;
    const bool qact = qh * 32 < L;
    __syncthreads();
    if (tid < L * 4) { const int t = tid >> 2, h2 = tid & 3; cumT[h2 * 64 + t] = ((const float*)(p.ws + W_CUMB))[(size_t)row0 * 4 + tid]; dtT[h2 * 64 + t] = ((const float*)(p.ws + W_DTB))[(size_t)row0 * 4 + tid]; }
    {
        for (int i = 0; i < (L >> 2); ++i) { const int s = i * 4 + g; const f32x4 v = *(const f32x4*)(xact + (size_t)(row0 + s) * 768 + hh * 64 + li * 4);
#pragma unroll
            for (int c = 0; c < 4; ++c) xT[(li * 4 + c) * 72 + s] = f2bf(v[c]); }
    }
    f32x4 yt[2][4];
#pragma unroll
    for (int qb = 0; qb < 2; ++qb)
#pragma unroll
        for (int pb = 0; pb < 4; ++pb) yt[qb][pb] = (f32x4){0.f, 0.f, 0.f, 0.f};
    bf16x8 Cf[2][4];
    f32x4 cb[2][4];
    if (qact) {
#pragma unroll
        for (int qb = 0; qb < 2; ++qb)
#pragma unroll
            for (int ks = 0; ks < 4; ++ks) Cf[qb][ks] = *(const bf16x8*)(xb16 + (size_t)(row0 + qh * 32 + qb * 16 + li) * 512 + 256 + gi * 128 + ks * 32 + g * 8);
        {   bf16x8 Bf[4][4];
#pragma unroll
            for (int sb = 0; sb < 4; ++sb)
#pragma unroll
                for (int ks = 0; ks < 4; ++ks) if (sb * 16 < L) Bf[sb][ks] = *(const bf16x8*)(xb16 + (size_t)(row0 + sb * 16 + li) * 512 + gi * 128 + ks * 32 + g * 8);
#pragma unroll
            for (int sb = 0; sb < 4; ++sb) {
                if (sb * 16 < L) {
#pragma unroll
                    for (int qb = 0; qb < 2; ++qb) { f32x4 a = (f32x4){0.f, 0.f, 0.f, 0.f};
#pragma unroll
                        for (int ks = 0; ks < 4; ++ks) a = __builtin_amdgcn_mfma_f32_16x16x32_bf16(Bf[sb][ks], Cf[qb][ks], a, 0, 0, 0);
                        cb[qb][sb] = a; }
                } else { cb[0][sb] = (f32x4){0.f, 0.f, 0.f, 0.f}; cb[1][sb] = (f32x4){0.f, 0.f, 0.f, 0.f}; }
            }
        }
        {
            bf16x8 Hf[4][4];
#pragma unroll
            for (int pb = 0; pb < 4; ++pb)
#pragma unroll
                for (int ks = 0; ks < 4; ++ks) { const size_t ho = ((size_t)hh * 64 + pb * 16 + li) * 128 + ks * 32 + g * 8; Hf[pb][ks] = it.prompt ? *(const bf16x8*)(hs16 + ho) : frag_from_f32(hst + ho); }
#pragma unroll
            for (int pb = 0; pb < 4; ++pb)
#pragma unroll
                for (int qb = 0; qb < 2; ++qb)
#pragma unroll
                    for (int ks = 0; ks < 4; ++ks) yt[qb][pb] = __builtin_amdgcn_mfma_f32_16x16x32_bf16(Hf[pb][ks], Cf[qb][ks], yt[qb][pb], 0, 0, 0);
        }
    }
    __syncthreads();
    float ssq[2] = {0.f, 0.f};
    f32x4 vv[2][4];
    if (qact) {
        bf16x8 Wf[2][2];
#pragma unroll
        for (int qb = 0; qb < 2; ++qb) {
            const int q = qh * 32 + qb * 16 + li; const float cq = cumT[hh * 64 + q]; const float eq = __expf(cq);
#pragma unroll
            for (int pb = 0; pb < 4; ++pb) yt[qb][pb] *= eq;
            float wv[4][4];
#pragma unroll
            for (int sb = 0; sb < 4; ++sb) {
                if (sb * 16 < L) {
                    const f32x4 cs = *(const LAS f32x4*)(cumT + hh * 64 + sb * 16 + g * 4), ds = *(const LAS f32x4*)(dtT + hh * 64 + sb * 16 + g * 4);
#pragma unroll
                    for (int j = 0; j < 4; ++j) { const int s = sb * 16 + g * 4 + j; wv[sb][j] = s <= q ? cb[qb][sb][j] * __expf(cq - cs[j]) * ds[j] : 0.f; }
                } else {
#pragma unroll
                    for (int j = 0; j < 4; ++j) wv[sb][j] = 0.f; }
            }
#pragma unroll
            for (int kst = 0; kst < 2; ++kst) { u32x4 w; w.x = cvt_pk_bf16(wv[2 * kst][0], wv[2 * kst][1]); w.y = cvt_pk_bf16(wv[2 * kst][2], wv[2 * kst][3]);
                w.z = cvt_pk_bf16(wv[2 * kst + 1][0], wv[2 * kst + 1][1]); w.w = cvt_pk_bf16(wv[2 * kst + 1][2], wv[2 * kst + 1][3]); Wf[qb][kst] = __builtin_bit_cast(bf16x8, w); }
        }
#pragma unroll
        for (int kst = 0; kst < 2; ++kst) {
            if (kst * 32 < L) {
#pragma unroll
                for (int pb = 0; pb < 4; ++pb) {
                    const u32x2 va = *(const LAS u32x2*)(xT + (pb * 16 + li) * 72 + kst * 32 + g * 4), vb2 = *(const LAS u32x2*)(xT + (pb * 16 + li) * 72 + kst * 32 + 16 + g * 4);
                    const u32x4 vc = {va.x, va.y, vb2.x, vb2.y}; const bf16x8 xf = __builtin_bit_cast(bf16x8, vc);
#pragma unroll
                    for (int qb = 0; qb < 2; ++qb) yt[qb][pb] = __builtin_amdgcn_mfma_f32_16x16x32_bf16(xf, Wf[qb][kst], yt[qb][pb], 0, 0, 0);
                }
            }
        }
        const float Dh = p.in[I_SD][l * 4 + hh];
#pragma unroll
        for (int qb = 0; qb < 2; ++qb) { const size_t row = (size_t)(row0 + qh * 32 + qb * 16 + li);
#pragma unroll
            for (int pb = 0; pb < 4; ++pb) { const int pc = hh * 64 + pb * 16 + g * 4;
                const f32x4 xq = *(const f32x4*)(xact + row * 768 + pc), z = *(const f32x4*)(proj + row * NIN + 2048 + pc);
                f32x4 v = yt[qb][pb] + Dh * xq;
#pragma unroll
                for (int j = 0; j < 4; ++j) { v[j] *= silu_f(z[j]); ssq[qb] += v[j] * v[j]; }
                vv[qb][pb] = v; }
            ssq[qb] += __shfl_xor(ssq[qb], 16); ssq[qb] += __shfl_xor(ssq[qb], 32);
            if (g == 0) ssqp[hh * 64 + qh * 32 + qb * 16 + li] = ssq[qb]; }
    }
    __syncthreads();
    if (qact) {
#pragma unroll
        for (int qb = 0; qb < 2; ++qb) { const int q = qh * 32 + qb * 16 + li; const float tot = ssqp[q] + ssqp[64 + q] + ssqp[128 + q] + ssqp[192 + q];
            const float r = rsqrtf(tot * (1.f / 256.f) + EPS); const size_t row = (size_t)(row0 + q);
#pragma unroll
            for (int pb = 0; pb < 4; ++pb) { const int pc = hh * 64 + pb * 16 + g * 4; const f32x4 w = *(const f32x4*)(p.in[I_SNW] + l * 256 + pc); const f32x4 o = (vv[qb][pb] * r) * w;
                u32x2 pk; pk.x = cvt_pk_bf16(o[0], o[1]); pk.y = cvt_pk_bf16(o[2], o[3]);
                *(u32x2*)((bf16_t*)(p.ws + W_MIX) + row * DM + 768 + pc) = pk; } }
    }
    __syncthreads();
}

constexpr int NPH = 2 + 2 * 12;
__global__ void __launch_bounds__(512, 2) mega(Params p) {
    extern __shared__ __attribute__((aligned(16))) unsigned char smem[];
    LAS unsigned char* lds = (LAS unsigned char*)smem;
    cg::grid_group grid = cg::this_grid();
    const int bid = blockIdx.x, nb = gridDim.x;
    int ph = 0;
    unsigned* barw = (unsigned*)(p.ws + W_BAR);
    volatile LAS unsigned* bst = (volatile LAS unsigned*)(lds + LDS_MAIN);
    XcdBarrier xb; xb.bar = barw; xb.x = 0; xb.st = bst;
#if COOP
    if (threadIdx.x < 4) bst[threadIdx.x] = 0u;
    if (bid == 0) for (int i = threadIdx.x; i < XCD_BAR_WORDS; i += 512) barw[i] = 0u;
#endif
#define PH_BEGIN if (ph >= p.ph_lo && ph < p.ph_hi) {
#define PH_END if (ph + 1 < p.ph_hi) for (int rs = 0; rs < REP_SYNC; ++rs) xcd_barrier(xb); } ++ph;
    PH_BEGIN for (int rep = 0; rep < REP_PREP; ++rep) prep_phase(p, lds, bid, nb);
        if (ph + 1 < p.ph_hi) { grid.sync(); xb = xcd_barrier_post(barw, bst); } } ++ph;
    PH_BEGIN for (int rep = 0; rep < REP_N0; ++rep) norm_phase(p, true, false, 0, 0, 0.f, 0, 0, 0, 1, bid, nb); PH_END
    for (int l = 0; l < 2; ++l) {
        const bf16_t* H = (const bf16_t*)(p.ws + W_H); const bf16_t* ACT = (const bf16_t*)(p.ws + W_ACT); const bf16_t* MIX = (const bf16_t*)(p.ws + W_MIX);
        for (int f = 0; f < 2; ++f) {
            if (f == 1) {
                PH_BEGIN {
                    pg8::Gemm g{H, (const bf16_t*)(p.ws + W_IN) + (size_t)l * NIN * DM, DM, DM}; pg8::StaticOrder S; S.init(TT, NIN, DM, nb, bid);
                    pg8::EpiIn E{(float*)(p.ws + W_PROJ), (bf16_t*)(p.ws + W_QB), (bf16_t*)(p.ws + W_KB), (bf16_t*)(p.ws + W_VB),
                                 p.out + O_PK + (size_t)l * TP * 512, p.out + O_SK + (size_t)l * TS * 512, p.out + O_PV + (size_t)l * TP * 512, p.out + O_SV + (size_t)l * TS * 512};
                    for (int rep = 0; rep < REP_IN; ++rep) pg8::gemm_phase(lds, g, S, E);
                    {
                        const int first = (66 * 13) % nb; if (bid >= first) { const int rel = bid - first, st = nb - first;
                            wconv(p, lds, WT_OUT + l * 64, 64, (l * 2 + 1) * 352, 352, WT_D + (l * 2 + 1) * 176, 176, rel, st); } } } PH_END
                PH_BEGIN {
                    for (int s = 0; s < 2; ++s) {
                        if (((s ^ (bid >> 3)) & 1) == 0) { for (int rep = 0; rep < REP_ATTP; ++rep) for (int it = bid; it < 256; it += nb) attn_prompt_item(p, l, it, lds); }
                        else { for (int rep = 0; rep < REP_ATTS; ++rep) attn_sample_block(p, l, bid, nb, lds); } }
                    for (int rep = 0; rep < REP_LRU1; ++rep) { for (int it = bid; it < 256; it += nb) lru_local_item(p, l, it, lds); for (int k = 0; k < 16; ++k) if ((32 + k) % nb == bid) lru_local_item(p, l, 256 + k, lds); }
                    for (int rep = 0; rep < REP_SSD1; ++rep) { for (int it = bid; it < 256; it += nb) ssd1_item(p, l, it, lds); for (int k = 0; k < 16; ++k) if ((16 + k) % nb == bid) ssd1_item(p, l, 256 + k, lds); } } PH_END
                for (int sub = 0; sub < 2; ++sub) {
                    PH_BEGIN {
                        if (sub == 0) {
                            for (int it = bid; it < 384; it += nb) ssd_scan_item(p, l, it);
                            for (int rep = 0; rep < REP_LRUF; ++rep) for (int it = bid; it < NCI; it += nb) lru_final_item(p, l, it);
                            for (int rep = 0; rep < REP_COMB; ++rep) for (int it = bid; it < 128; it += nb) attn_sample_combine(p, it);
                        }
                        const int first = sub == 0 ? 256 + (nb - 1 - bid) : bid, limit = sub == 0 ? NCI : 256;
                        for (int rep = 0; rep < REP_M3; ++rep) for (int it = first; it < limit; it += nb) ssd3_item(p, l, it, lds);
                    } PH_END
                }
                PH_BEGIN {
                    pg8::Gemm g{MIX, (const bf16_t*)(p.ws + W_OUT) + (size_t)l * DM * DM, DM, DM}; pg8::SampleSplitOrder S; S.init(DM, DM, nb, bid);
                    pg8::EpiY E{(bf16_t*)(p.ws + W_Y), (float*)(p.ws + W_YS)}; for (int rep = 0; rep < REP_OUT; ++rep) pg8::gemm_phase(lds, g, S, E); } PH_END
                PH_BEGIN for (int rep = 0; rep < REP_NORM; ++rep) norm_phase(p, false, false, l, 1, 1.0f, l, 2, 4, (l * 3 + 1) & 1, bid, nb); PH_END
            }
            PH_BEGIN {
                pg8::Gemm g{H, (const bf16_t*)(p.ws + W_GU) + (size_t)(l * 2 + f) * NGU * DM, DM, DM}; pg8::StaticOrder S; S.init(TT, NGU, DM, nb, bid);
                pg8::EpiGU E{(bf16_t*)(p.ws + W_ACT)}; for (int rep = 0; rep < REP_GU; ++rep) pg8::gemm_phase(lds, g, S, E);
                {
                    const int first = (66 * 22) % nb; if (bid >= first) { const int rel = bid - first, st = nb - first;
                        const int lo0 = f == 0 ? WT_D + (l * 2) * 176 : 2 * 352, n0 = f == 0 ? 176 : (l == 0 ? 352 : 0), lo1 = WT_IN + l * 208, n1 = f == 0 ? 208 : 0;
                        wconv(p, lds, lo0, n0, lo1, n1, 0, 0, rel, st); } } } PH_END
            PH_BEGIN {
                pg8::Gemm g{ACT, (const bf16_t*)(p.ws + W_D) + (size_t)(l * 2 + f) * DM * DFF, DFF, DFF}; pg8::SampleSplitOrder S; S.init(DM, DFF, nb, bid);
                pg8::EpiY E{(bf16_t*)(p.ws + W_Y), (float*)(p.ws + W_YS)}; for (int rep = 0; rep < REP_DN; ++rep) pg8::gemm_phase(lds, g, S, E); } PH_END
            if (f == 0) { PH_BEGIN for (int rep = 0; rep < REP_NORM; ++rep) norm_phase(p, false, false, l, 0, 0.5f, l, 1, 11, (l * 3) & 1, bid, nb); PH_END }
            else { PH_BEGIN for (int rep = 0; rep < REP_NORM; ++rep) norm_phase(p, false, l == 1, l, 2, 0.5f, l + 1, 0, 11, (l * 3 + 2) & 1, bid, nb); PH_END }
        }
    }
#undef PH_BEGIN
#undef PH_END
}

extern "C" void kernel_launch(void* const* d_in, const int* in_sizes, int n_in, void* d_out, int out_size, void* d_ws, size_t ws_size, hipStream_t stream) {
    static int grid = 0;
    if (grid == 0) {
        if (n_in != 34 || ws_size < W_END) { fprintf(stderr, "kernel_launch: unexpected n_in %d or ws %zu < %zu\n", n_in, ws_size, (size_t)W_END); grid = -1; return; }
        int dev = 0, cus = 0, per_cu = 0;
        (void)hipGetDevice(&dev); (void)hipDeviceGetAttribute(&cus, hipDeviceAttributeMultiprocessorCount, dev);
        if (hipFuncSetAttribute((const void*)mega, hipFuncAttributeMaxDynamicSharedMemorySize, LDS_BYTES) != hipSuccess) { fprintf(stderr, "kernel_launch: hipFuncSetAttribute failed\n"); grid = -1; return; }
        if (hipOccupancyMaxActiveBlocksPerMultiprocessor(&per_cu, (const void*)mega, 512, LDS_BYTES) != hipSuccess || per_cu < 1) { fprintf(stderr, "kernel_launch: occupancy query says %d\n", per_cu); per_cu = 1; }
        (void)hipGetLastError();
        grid = cus;
    }
    if (grid < 0) return;
    Params p{};
    for (int i = 0; i < 34; ++i) p.in[i] = (const float*)d_in[i];
    p.out = (float*)d_out; p.ws = (unsigned char*)d_ws;
#if COOP
    p.ph_lo = 0; p.ph_hi = NPH;
    void* args[] = {&p};
    hipError_t e = hipLaunchCooperativeKernel((const void*)mega, dim3(grid), dim3(512), args, LDS_BYTES, stream);
    if (e != hipSuccess) fprintf(stderr, "cooperative launch failed: %s (grid %d)\n", hipGetErrorString(e), grid);
#else
    for (int ph = 0; ph < NPH; ++ph) { p.ph_lo = ph; p.ph_hi = ph + 1; hipLaunchKernelGGL(mega, dim3(grid), dim3(512), LDS_BYTES, stream, p); }
#endif
}
```
